# Optimizing an MI355X kernel written in HIP

```python
import jax
import jax.numpy as jnp
from jax import lax
import numpy as np

D_MODEL = 1024
BATCH = 4
SEQ = 4096
DEPTH = 4

N_EVEN = (DEPTH + 1) // 2
N_ODD = DEPTH // 2

MLA_HEADS = 8
MLA_NOPE = 64
MLA_ROPE = 32
MLA_V = 64
MLA_Q_RANK = 256
MLA_KV_RANK = 128
MLA_COLS = MLA_Q_RANK + MLA_KV_RANK + MLA_ROPE
MLA_SCALE = (MLA_NOPE + MLA_ROPE) ** -0.5
Q_BLOCK = 128

GDN_HEADS = 8
GDN_DK = 64
GDN_DV = 64
GDN_CONV = 4
GDN_CHUNK = 64
GDN_QKV = GDN_HEADS * (2 * GDN_DK + GDN_DV)
GDN_COLS = GDN_QKV + 2 * GDN_HEADS + GDN_HEADS * GDN_DV

HY_IN = MLA_COLS + GDN_COLS
HY_MIX = MLA_HEADS * MLA_V + GDN_HEADS * GDN_DV

RET_HEADS = 8
RET_DK = D_MODEL // RET_HEADS
RET_DV = 2 * D_MODEL // RET_HEADS
RET_CHUNK = 128
RET_IN = RET_HEADS * (2 * RET_DK + 2 * RET_DV)
RET_MIX = RET_HEADS * RET_DV

N_GROUPS = 4
EXPERTS_PER_GROUP = 8
N_EXPERTS = N_GROUPS * EXPERTS_PER_GROUP
TOP_K_IN_GROUP = 2
EXPERT_FF = 512
MOE_BLOCK = 128

ROPE_BASE = 10000.0
LN_EPS = 1e-5
RMS_EPS = 1e-6
DEEPNORM_ALPHA = (2.0 * DEPTH) ** 0.25
DEEPNORM_BETA = (8.0 * DEPTH) ** -0.25
N_MOD = 6

kernel_name = 'hybrid_mla_gdn_retention_hmoe_deepnorm'


def layer_norm(x, g, b):
    xf = x.astype(jnp.float32)
    mu = jnp.mean(xf, -1, keepdims=True)
    var = jnp.mean(jnp.square(xf - mu), -1, keepdims=True)
    return ((xf - mu) * lax.rsqrt(var + LN_EPS)).astype(x.dtype) * g + b


def rms_norm(x, g):
    xf = x.astype(jnp.float32)
    return (xf * lax.rsqrt(jnp.mean(xf * xf, -1, keepdims=True) + RMS_EPS)).astype(x.dtype) * g


def l2_normalize(x):
    xf = x.astype(jnp.float32)
    return (xf * lax.rsqrt(jnp.sum(xf * xf, -1, keepdims=True) + RMS_EPS)).astype(x.dtype)


def rope_tables(positions, dim):
    inv_freq = ROPE_BASE ** (-jnp.arange(0, dim, 2, dtype=jnp.float32) / dim)
    ang = positions.astype(jnp.float32)[..., None] * inv_freq
    return jnp.cos(ang), jnp.sin(ang)


def apply_rope(x, cos, sin):
    x1, x2 = jnp.split(x, 2, axis=-1)
    c = cos[:, :, None, :].astype(x.dtype)
    s = sin[:, :, None, :].astype(x.dtype)
    return jnp.concatenate([x1 * c - x2 * s, x1 * s + x2 * c], axis=-1)


def to_chunks(x, chunk):
    B, S, H, d = x.shape
    return x.reshape(B, S // chunk, chunk, H, d).transpose(0, 3, 1, 2, 4).astype(jnp.float32)


def from_chunks(x):
    B, H, N, C, d = x.shape
    return x.transpose(0, 2, 3, 1, 4).reshape(B, N * C, H, d)


def causal_attention_blocks(q, k, v):
    B, S, H, Dq = q.shape
    Dv = v.shape[-1]
    nb = S // Q_BLOCK
    qb = jnp.moveaxis(q.reshape(B, nb, Q_BLOCK, H, Dq), 1, 0)
    kpos = jnp.arange(S)

    def one_block(args):
        q_blk, blk = args
        s = jnp.einsum('bqhd,bkhd->bhqk', q_blk, k).astype(jnp.float32)
        qpos = blk * Q_BLOCK + jnp.arange(Q_BLOCK)
        s = jnp.where(kpos[None, :] <= qpos[:, None], s, -jnp.inf)
        p = jax.nn.softmax(s, axis=-1).astype(v.dtype)
        return jnp.einsum('bhqk,bkhd->bqhd', p, v)

    out = lax.map(one_block, (qb, jnp.arange(nb)))
    return jnp.moveaxis(out, 0, 1).reshape(B, S, H, Dv)


def latent_attention(h_mla, positions, q_norm, w_uq, kv_norm, w_ukv):
    B, S, _ = h_mla.shape
    q_lat, kv_lat, k_rope = jnp.split(h_mla, [MLA_Q_RANK, MLA_Q_RANK + MLA_KV_RANK], axis=-1)
    q = (rms_norm(q_lat, q_norm) @ w_uq).reshape(B, S, MLA_HEADS, MLA_NOPE + MLA_ROPE)
    kv = (rms_norm(kv_lat, kv_norm) @ w_ukv).reshape(B, S, MLA_HEADS, MLA_NOPE + MLA_V)
    q_nope, q_rope = jnp.split(q, [MLA_NOPE], axis=-1)
    k_nope, v = jnp.split(kv, [MLA_NOPE], axis=-1)
    cos, sin = rope_tables(positions, MLA_ROPE)
    q_rope = apply_rope(q_rope, cos, sin)
    k_rope = jnp.broadcast_to(apply_rope(k_rope[:, :, None, :], cos, sin), (B, S, MLA_HEADS, MLA_ROPE))
    q = jnp.concatenate([q_nope, q_rope], axis=-1) * MLA_SCALE
    k = jnp.concatenate([k_nope, k_rope], axis=-1)
    o = causal_attention_blocks(q, k, v)
    return o.reshape(B, S, MLA_HEADS * MLA_V)


def causal_depthwise_conv(x, w):
    K = w.shape[0]
    return lax.conv_general_dilated(x, w[:, None, :].astype(x.dtype), window_strides=(1,), padding=[(K - 1, 0)],
                                    dimension_numbers=('NWC', 'WIO', 'NWC'), feature_group_count=x.shape[-1])


def chunk_gated_delta_rule(q, k, v, log_alpha, beta):
    B, S, H, DK = q.shape
    DV = v.shape[-1]
    C = GDN_CHUNK
    N = S // C
    qc, kc, vc = (to_chunks(t, C) for t in (q, k, v))
    bc = beta.reshape(B, N, C, H).transpose(0, 3, 1, 2).astype(jnp.float32)
    g = jnp.cumsum(log_alpha.reshape(B, N, C, H).transpose(0, 3, 1, 2), axis=-1)
    tril = jnp.tril(jnp.ones((C, C), bool))
    strict = jnp.tril(jnp.ones((C, C), bool), -1)
    gdiff = g[..., :, None] - g[..., None, :]
    decay = jnp.where(tril, jnp.exp(jnp.where(tril, gdiff, 0.0)), 0.0)
    kb = kc * bc[..., None]
    L = jnp.where(strict, jnp.einsum('bhnid,bhnjd->bhnij', kb, kc) * decay, 0.0)
    eye = jnp.eye(C, dtype=jnp.float32)
    T = lax.linalg.triangular_solve(eye + L, jnp.broadcast_to(eye, L.shape), left_side=True, lower=True)
    u = jnp.einsum('bhnij,bhnje->bhnie', T, vc * bc[..., None])
    w = jnp.einsum('bhnij,bhnjd->bhnid', T, kb * jnp.exp(g)[..., None])
    a_intra = jnp.where(tril, jnp.einsum('bhnid,bhnjd->bhnij', qc, kc) * decay, 0.0)

    def step(state, xs):
        q_i, k_i, u_i, w_i, g_i, a_i = xs
        v_new = u_i - jnp.einsum('bhcd,bhde->bhce', w_i, state)
        o_i = jnp.einsum('bhcd,bhde->bhce', q_i * jnp.exp(g_i)[..., None], state) + jnp.einsum('bhij,bhje->bhie', a_i, v_new)
        g_last = g_i[..., -1]
        k_dec = k_i * jnp.exp(g_last[..., None] - g_i)[..., None]
        state = state * jnp.exp(g_last)[..., None, None] + jnp.einsum('bhcd,bhce->bhde', k_dec, v_new)
        return state, o_i

    state0 = jnp.zeros((B, H, DK, DV), jnp.float32)
    xs = tuple(jnp.moveaxis(t, 2, 0) for t in (qc, kc, u, w, g, a_intra))
    _, o = lax.scan(step, state0, xs)
    return from_chunks(jnp.moveaxis(o, 0, 2)).astype(v.dtype)


def gated_deltanet(h_gdn, conv_w, a_log, dt_bias, o_norm):
    B, S, _ = h_gdn.shape
    qkv, a, b, gate = jnp.split(h_gdn, [GDN_QKV, GDN_QKV + GDN_HEADS, GDN_QKV + 2 * GDN_HEADS], axis=-1)
    qkv = jax.nn.silu(causal_depthwise_conv(qkv, conv_w))
    q, k, v = jnp.split(qkv, [GDN_HEADS * GDN_DK, 2 * GDN_HEADS * GDN_DK], axis=-1)
    q = l2_normalize(q.reshape(B, S, GDN_HEADS, GDN_DK)) * (GDN_DK ** -0.5)
    k = l2_normalize(k.reshape(B, S, GDN_HEADS, GDN_DK))
    v = v.reshape(B, S, GDN_HEADS, GDN_DV)
    beta = jax.nn.sigmoid(b.astype(jnp.float32))
    log_alpha = -jnp.exp(a_log.astype(jnp.float32)) * jax.nn.softplus(a.astype(jnp.float32) + dt_bias.astype(jnp.float32))
    o = chunk_gated_delta_rule(q, k, v, log_alpha, beta)
    o = rms_norm(o, o_norm) * jax.nn.silu(gate.reshape(B, S, GDN_HEADS, GDN_DV))
    return o.reshape(B, S, GDN_HEADS * GDN_DV)


def mla_gdn_mixer(h, positions, w_in, q_norm, w_uq, kv_norm, w_ukv, conv_w, a_log, dt_bias, o_norm, w_out):
    proj = h @ w_in
    h_mla, h_gdn = jnp.split(proj, [MLA_COLS], axis=-1)
    y_mla = latent_attention(h_mla, positions, q_norm, w_uq, kv_norm, w_ukv)
    y_gdn = gated_deltanet(h_gdn, conv_w, a_log, dt_bias, o_norm)
    return jnp.concatenate([y_mla, y_gdn], axis=-1) @ w_out


def chunkwise_retention(q, k, v):
    B, S, H, DK = q.shape
    DV = v.shape[-1]
    C = RET_CHUNK
    log_gamma = jnp.log(1.0 - 2.0 ** (-5.0 - jnp.arange(H, dtype=jnp.float32)))
    idx = jnp.arange(C, dtype=jnp.float32)
    diff = idx[:, None] - idx[None, :]
    causal = diff >= 0
    decay = jnp.where(causal, jnp.exp(jnp.where(causal, diff, 0.0) * log_gamma[:, None, None]), 0.0)
    cross_decay = jnp.exp((idx + 1.0) * log_gamma[:, None])
    key_decay = jnp.exp((C - 1.0 - idx) * log_gamma[:, None])
    chunk_decay = jnp.exp(C * log_gamma)
    qc, kc, vc = (to_chunks(t, C) for t in (q, k, v))
    scores = jnp.einsum('bhnid,bhnjd->bhnij', qc, kc) * decay[None, :, None]
    inner = jnp.einsum('bhnij,bhnje->bhnie', scores, vc)

    def step(state, xs):
        q_i, k_i, v_i = xs
        o_cross = jnp.einsum('bhcd,bhde->bhce', q_i, state) * cross_decay[None, :, :, None]
        state = state * chunk_decay[None, :, None, None] + jnp.einsum('bhcd,bhce->bhde', k_i * key_decay[None, :, :, None], v_i)
        return state, o_cross

    state0 = jnp.zeros((B, H, DK, DV), jnp.float32)
    xs = tuple(jnp.moveaxis(t, 2, 0) for t in (qc, kc, vc))
    _, cross = lax.scan(step, state0, xs)
    return from_chunks(inner + jnp.moveaxis(cross, 0, 2)).astype(v.dtype)


def retention_mixer(h, positions, w_in, gn_g, gn_b, w_out):
    B, S, _ = h.shape
    proj = h @ w_in
    q, k, v, gate = jnp.split(proj, [RET_HEADS * RET_DK, 2 * RET_HEADS * RET_DK, 2 * RET_HEADS * RET_DK + RET_MIX], axis=-1)
    cos, sin = rope_tables(positions, RET_DK)
    q = apply_rope(q.reshape(B, S, RET_HEADS, RET_DK), cos, sin) * (RET_DK ** -0.5)
    k = apply_rope(k.reshape(B, S, RET_HEADS, RET_DK), cos, sin)
    v = v.reshape(B, S, RET_HEADS, RET_DV)
    o = chunkwise_retention(q, k, v)
    o = layer_norm(o, gn_g.reshape(RET_HEADS, RET_DV), gn_b.reshape(RET_HEADS, RET_DV))
    return (jax.nn.silu(gate) * o.reshape(B, S, RET_MIX)) @ w_out


def routed_experts(xt, expert_id, weights, w_gate, w_up, w_down):
    T, D = xt.shape
    K = expert_id.shape[1]
    n = T * K
    flat_e = expert_id.reshape(n).astype(jnp.int32)
    flat_tok = jnp.repeat(jnp.arange(T, dtype=jnp.int32), K)
    flat_w = weights.reshape(n)
    order = jnp.argsort(flat_e)
    e_sorted = flat_e[order]
    tok_sorted = flat_tok[order]
    w_sorted = flat_w[order]
    counts = jnp.zeros((N_EXPERTS,), jnp.int32).at[flat_e].add(1)
    padded = (counts + MOE_BLOCK - 1) // MOE_BLOCK * MOE_BLOCK
    start = jnp.cumsum(counts) - counts
    pstart = jnp.cumsum(padded) - padded
    slot = pstart[e_sorted] + (jnp.arange(n, dtype=jnp.int32) - start[e_sorted])
    n_blocks = n // MOE_BLOCK + N_EXPERTS
    n_slots = n_blocks * MOE_BLOCK
    slot_tok = jnp.zeros((n_slots,), jnp.int32).at[slot].set(tok_sorted)
    block_start = jnp.arange(n_blocks, dtype=jnp.int32) * MOE_BLOCK
    block_expert = jnp.minimum(jnp.searchsorted(jnp.cumsum(padded), block_start, side='right'), N_EXPERTS - 1)
    xb = xt[slot_tok].reshape(n_blocks, MOE_BLOCK, D)

    def expert_block(args):
        xs, e = args
        hid = jax.nn.silu(xs @ w_gate[e]) * (xs @ w_up[e])
        return hid @ w_down[e]

    yb = lax.map(expert_block, (xb, block_expert)).reshape(n_slots, D)
    contrib = yb[slot] * w_sorted[:, None].astype(yb.dtype)
    return jax.ops.segment_sum(contrib, tok_sorted, num_segments=T)


def hierarchical_moe(h, w_group, b_group, w_expert, b_expert, w_gate, w_up, w_down):
    B, S, D = h.shape
    T = B * S
    xt = h.reshape(T, D)
    g_prob = jax.nn.softmax((xt @ w_group + b_group).astype(jnp.float32), axis=-1)
    g_top, g_idx = lax.top_k(g_prob, 1)
    e_logits_all = (xt @ w_expert + b_expert).astype(jnp.float32).reshape(T, N_GROUPS, EXPERTS_PER_GROUP)
    e_logits = jnp.take_along_axis(e_logits_all, g_idx[:, :, None], axis=1)[:, 0]
    e_top, e_idx = lax.top_k(e_logits, TOP_K_IN_GROUP)
    e_w = jax.nn.softmax(e_top, axis=-1)
    weights = g_top * e_w
    expert_id = g_idx * EXPERTS_PER_GROUP + e_idx
    y = routed_experts(xt, expert_id, weights, w_gate, w_up, w_down)
    return y.reshape(B, S, D)


def setup_inputs(seed: int = 0) -> dict:
    key = jax.random.key(seed)
    ks = iter(jax.random.split(key, 40))
    f32 = jnp.float32

    def nrm(shape, scale):
        return scale * jax.random.normal(next(ks), shape, f32)

    def gain(shape):
        return 1.0 + 0.01 * jax.random.normal(next(ks), shape, f32)

    x = nrm((BATCH, SEQ, D_MODEL), 1.0)
    c = nrm((BATCH, D_MODEL), 1.0)
    positions = jax.random.randint(next(ks), (BATCH, 1), 0, 1024, jnp.int32) + jnp.arange(SEQ, dtype=jnp.int32)[None, :]
    ada_w = nrm((DEPTH, D_MODEL, N_MOD * D_MODEL), 0.1 * D_MODEL ** -0.5)
    ada_b = nrm((DEPTH, N_MOD * D_MODEL), 0.01)
    ln_mix_g = gain((DEPTH, D_MODEL))
    ln_mix_b = nrm((DEPTH, D_MODEL), 0.01)
    ln_ffn_g = gain((DEPTH, D_MODEL))
    ln_ffn_b = nrm((DEPTH, D_MODEL), 0.01)
    hy_w_in = nrm((N_EVEN, D_MODEL, HY_IN), D_MODEL ** -0.5)
    mla_q_norm = gain((N_EVEN, MLA_Q_RANK))
    mla_w_uq = nrm((N_EVEN, MLA_Q_RANK, MLA_HEADS * (MLA_NOPE + MLA_ROPE)), MLA_Q_RANK ** -0.5)
    mla_kv_norm = gain((N_EVEN, MLA_KV_RANK))
    mla_w_ukv = nrm((N_EVEN, MLA_KV_RANK, MLA_HEADS * (MLA_NOPE + MLA_V)), MLA_KV_RANK ** -0.5)
    gdn_conv_w = nrm((N_EVEN, GDN_CONV, GDN_QKV), GDN_CONV ** -0.5)
    gdn_a_log = jnp.log(jax.random.uniform(next(ks), (N_EVEN, GDN_HEADS), f32, 1.0, 16.0))
    dt = jnp.exp(jnp.log(1e-3) + jax.random.uniform(next(ks), (N_EVEN, GDN_HEADS), f32) * (jnp.log(1e-1) - jnp.log(1e-3)))
    gdn_dt_bias = dt + jnp.log(-jnp.expm1(-dt))
    gdn_norm = gain((N_EVEN, GDN_DV))
    hy_w_out = nrm((N_EVEN, HY_MIX, D_MODEL), DEEPNORM_BETA * HY_MIX ** -0.5)
    ret_w_in = nrm((N_ODD, D_MODEL, RET_IN), D_MODEL ** -0.5)
    ret_gn_g = gain((N_ODD, RET_MIX))
    ret_gn_b = nrm((N_ODD, RET_MIX), 0.01)
    ret_w_out = nrm((N_ODD, RET_MIX, D_MODEL), DEEPNORM_BETA * RET_MIX ** -0.5)
    moe_w_group = nrm((DEPTH, D_MODEL, N_GROUPS), D_MODEL ** -0.5)
    moe_b_group = nrm((DEPTH, N_GROUPS), 0.01)
    moe_w_expert = nrm((DEPTH, D_MODEL, N_EXPERTS), D_MODEL ** -0.5)
    moe_b_expert = nrm((DEPTH, N_EXPERTS), 0.01)
    moe_w_gate = nrm((DEPTH, N_EXPERTS, D_MODEL, EXPERT_FF), D_MODEL ** -0.5)
    moe_w_up = nrm((DEPTH, N_EXPERTS, D_MODEL, EXPERT_FF), D_MODEL ** -0.5)
    moe_w_down = nrm((DEPTH, N_EXPERTS, EXPERT_FF, D_MODEL), DEEPNORM_BETA * EXPERT_FF ** -0.5)
    return {'x': x, 'c': c, 'positions': positions, 'ada_w': ada_w, 'ada_b': ada_b,
            'ln_mix_g': ln_mix_g, 'ln_mix_b': ln_mix_b, 'ln_ffn_g': ln_ffn_g, 'ln_ffn_b': ln_ffn_b,
            'hy_w_in': hy_w_in, 'mla_q_norm': mla_q_norm, 'mla_w_uq': mla_w_uq, 'mla_kv_norm': mla_kv_norm,
            'mla_w_ukv': mla_w_ukv, 'gdn_conv_w': gdn_conv_w, 'gdn_a_log': gdn_a_log, 'gdn_dt_bias': gdn_dt_bias,
            'gdn_norm': gdn_norm, 'hy_w_out': hy_w_out, 'ret_w_in': ret_w_in, 'ret_gn_g': ret_gn_g,
            'ret_gn_b': ret_gn_b, 'ret_w_out': ret_w_out, 'moe_w_group': moe_w_group, 'moe_b_group': moe_b_group,
            'moe_w_expert': moe_w_expert, 'moe_b_expert': moe_b_expert, 'moe_w_gate': moe_w_gate,
            'moe_w_up': moe_w_up, 'moe_w_down': moe_w_down}


def reference(x, c, positions, ada_w, ada_b, ln_mix_g, ln_mix_b, ln_ffn_g, ln_ffn_b,
              hy_w_in, mla_q_norm, mla_w_uq, mla_kv_norm, mla_w_ukv, gdn_conv_w, gdn_a_log, gdn_dt_bias,
              gdn_norm, hy_w_out, ret_w_in, ret_gn_g, ret_gn_b, ret_w_out, moe_w_group, moe_b_group,
              moe_w_expert, moe_b_expert, moe_w_gate, moe_w_up, moe_w_down):
    c_act = jax.nn.silu(c)
    for layer in range(DEPTH):
        mod = (c_act @ ada_w[layer] + ada_b[layer])[:, None, :]
        sh_m, sc_m, gt_m, sh_f, sc_f, gt_f = jnp.split(mod, N_MOD, axis=-1)
        h = x * (1.0 + sc_m) + sh_m
        i = layer // 2
        if layer % 2 == 0:
            y = mla_gdn_mixer(h, positions, hy_w_in[i], mla_q_norm[i], mla_w_uq[i], mla_kv_norm[i], mla_w_ukv[i],
                              gdn_conv_w[i], gdn_a_log[i], gdn_dt_bias[i], gdn_norm[i], hy_w_out[i])
        else:
            y = retention_mixer(h, positions, ret_w_in[i], ret_gn_g[i], ret_gn_b[i], ret_w_out[i])
        x = layer_norm(DEEPNORM_ALPHA * x + (1.0 + gt_m) * y, ln_mix_g[layer], ln_mix_b[layer])
        h = x * (1.0 + sc_f) + sh_f
        y = hierarchical_moe(h, moe_w_group[layer], moe_b_group[layer], moe_w_expert[layer], moe_b_expert[layer],
                             moe_w_gate[layer], moe_w_up[layer], moe_w_down[layer])
        x = layer_norm(DEEPNORM_ALPHA * x + (1.0 + gt_f) * y, ln_ffn_g[layer], ln_ffn_b[layer])
    return x
```

```cpp
#include <hip/hip_runtime.h>
#include <cstdio>
#include <cstdint>

namespace {
constexpr int D = 1024, NB = 4, SEQ = 4096, T = NB * SEQ, DEPTH = 4;
constexpr int MLA_H = 8, MLA_NOPE = 64, MLA_ROPE = 32, MLA_V = 64, MLA_QR = 256, MLA_KVR = 128, MLA_COLS = 416;
constexpr int GDN_H = 8, GDN_DK = 64, GDN_DV = 64, GDN_QKV = 1536, GDN_COLS = 2064;
constexpr int HY_IN = 2480;
constexpr int RET_H = 8, RET_DK = 128, RET_DV = 256, RET_IN = 6144, RET_MIX = 2048;
constexpr int NG = 4, EPG = 8, NE = 32, FF = 512;
constexpr int XP_ROWS = 2 * T + NE * 256;
constexpr float LN_EPS = 1e-5f, RMS_EPS = 1e-6f;
constexpr float ALPHA = 1.681792830507429f;
constexpr size_t MiB = 1u << 20;
constexpr size_t WS_CTL = 0, WS_MOD = 1 * MiB, WS_H = 2 * MiB, WS_Y = 66 * MiB, WS_R1 = 130 * MiB, WS_R2 = 532 * MiB, WS_END = 702 * MiB;

__device__ __forceinline__ float silu_f(float x) { return x / (1.f + __expf(-x)); }

__global__ void k_mod(const float* c, const float* ada_w, const float* ada_b, float* mod) {
    const int idx = blockIdx.x * blockDim.x + threadIdx.x;
    if (idx >= DEPTH * 6 * D) return;
    const int l = idx / (6 * D), n = idx % (6 * D);
    float acc[NB] = {0.f, 0.f, 0.f, 0.f};
    const float* w = ada_w + (size_t)l * D * 6 * D + n;
    for (int k = 0; k < D; ++k) {
        const float wv = w[(size_t)k * 6 * D];
#pragma unroll
        for (int b = 0; b < NB; ++b) acc[b] += silu_f(c[b * D + k]) * wv;
    }
#pragma unroll
    for (int b = 0; b < NB; ++b) mod[((size_t)l * NB + b) * 6 * D + n] = acc[b] + ada_b[l * 6 * D + n];
}

__global__ void k_modulate(const float* x, const float* mod_lb  , int which  , float* h) {
    const size_t i = (size_t)blockIdx.x * blockDim.x + threadIdx.x;
    if (i >= (size_t)T * D) return;
    const int t = (int)(i / D), d = (int)(i % D), b = t / SEQ;
    const float* m = mod_lb + (size_t)b * 6 * D + which * 3 * D;
    h[i] = x[i] * (1.f + m[D + d]) + m[d];
}

__global__ void __launch_bounds__(256) k_gemm(const float* A, int lda, const float* B, int ldb, float* C, int ldc, int M, int N, int K,
                                                const int* tile_expert, size_t b_expert_stride, const int* n_tiles_used) {
    __shared__ float As[16][68];
    __shared__ float Bs[16][68];
    const int bm = blockIdx.y * 64, bn = blockIdx.x * 64;
    if (n_tiles_used && (bm / 256) >= *n_tiles_used) return;
    if (tile_expert) B += (size_t)tile_expert[bm / 256] * b_expert_stride;
    const int tx = threadIdx.x & 15, ty = threadIdx.x >> 4;
    float acc[4][4] = {};
    for (int k0 = 0; k0 < K; k0 += 16) {
        for (int i = threadIdx.x; i < 64 * 16; i += 256) {
            const int r = i / 16, kk = i % 16;
            As[kk][r] = A[(size_t)(bm + r) * lda + k0 + kk];
        }
        for (int i = threadIdx.x; i < 16 * 64; i += 256) {
            const int kk = i / 64, cc = i % 64;
            Bs[kk][cc] = (bn + cc < N) ? B[(size_t)(k0 + kk) * ldb + bn + cc] : 0.f;
        }
        __syncthreads();
#pragma unroll
        for (int kk = 0; kk < 16; ++kk) {
            float a[4], b[4];
#pragma unroll
            for (int i = 0; i < 4; ++i) { a[i] = As[kk][ty * 4 + i]; b[i] = Bs[kk][tx * 4 + i]; }
#pragma unroll
            for (int i = 0; i < 4; ++i)
#pragma unroll
                for (int j = 0; j < 4; ++j) acc[i][j] += a[i] * b[j];
        }
        __syncthreads();
    }
#pragma unroll
    for (int i = 0; i < 4; ++i)
#pragma unroll
        for (int j = 0; j < 4; ++j) { const int c = bn + tx * 4 + j; if (c < N) C[(size_t)(bm + ty * 4 + i) * ldc + c] = acc[i][j]; }
}

__global__ void k_mla_norm(const float* proj, const float* qg, const float* kvg, float* qn, float* kvn) {
    const int t = blockIdx.x * 4 + (threadIdx.x >> 6), lane = threadIdx.x & 63;
    const float* p = proj + (size_t)t * HY_IN;
    float v[4], s = 0.f;
#pragma unroll
    for (int j = 0; j < 4; ++j) { v[j] = p[lane + 64 * j]; s += v[j] * v[j]; }
    for (int o = 32; o >= 1; o >>= 1) s += __shfl_xor(s, o);
    const float r = rsqrtf(s / 256.f + RMS_EPS);
#pragma unroll
    for (int j = 0; j < 4; ++j) qn[(size_t)t * 256 + lane + 64 * j] = v[j] * r * qg[lane + 64 * j];
    float w[2], s2 = 0.f;
#pragma unroll
    for (int j = 0; j < 2; ++j) { w[j] = p[256 + lane + 64 * j]; s2 += w[j] * w[j]; }
    for (int o = 32; o >= 1; o >>= 1) s2 += __shfl_xor(s2, o);
    const float r2 = rsqrtf(s2 / 128.f + RMS_EPS);
#pragma unroll
    for (int j = 0; j < 2; ++j) kvn[(size_t)t * 128 + lane + 64 * j] = w[j] * r2 * kvg[lane + 64 * j];
}

__global__ void k_mla_rope(float* qf, const float* proj, const int* positions, float* krope) {
    const int idx = blockIdx.x * blockDim.x + threadIdx.x;
    if (idx >= T * 9 * 16) return;
    const int t = idx / 144, r = idx % 144, hh = r / 16, i = r % 16;
    const float pos = (float)positions[t];
    const float inv = powf(10000.f, -(float)(2 * i) / 32.f);
    const float ang = pos * inv, c = cosf(ang), s = sinf(ang);
    if (hh < 8) {
        float* q = qf + (size_t)t * 768 + hh * 96 + 64;
        const float x1 = q[i], x2 = q[i + 16];
        q[i] = x1 * c - x2 * s; q[i + 16] = x1 * s + x2 * c;
    } else {
        const float* k = proj + (size_t)t * HY_IN + 384;
        const float x1 = k[i], x2 = k[i + 16];
        krope[(size_t)t * 32 + i] = x1 * c - x2 * s; krope[(size_t)t * 32 + i + 16] = x1 * s + x2 * c;
    }
}

__global__ void __launch_bounds__(64) k_attn(const float* qf, const float* kvf, const float* krope, float* mix) {
    const int qi = blockIdx.x * 64 + threadIdx.x;
    const int h = blockIdx.y, b = blockIdx.z;
    const int t = b * SEQ + qi;
    const float scale = 0.10206207261596577f;
    float q[96];
#pragma unroll
    for (int d = 0; d < 96; ++d) q[d] = qf[(size_t)t * 768 + h * 96 + d] * scale;
    float m = -1e30f, l = 0.f, o[64];
#pragma unroll
    for (int d = 0; d < 64; ++d) o[d] = 0.f;
    const int kmax = blockIdx.x * 64 + 63;
    for (int k = 0; k <= kmax; ++k) {
        const int tk = b * SEQ + k;
        const float* kp = kvf + (size_t)tk * 1024 + h * 128;
        const float* kr = krope + (size_t)tk * 32;
        float s = 0.f;
#pragma unroll
        for (int d = 0; d < 64; ++d) s += q[d] * kp[d];
#pragma unroll
        for (int d = 0; d < 32; ++d) s += q[64 + d] * kr[d];
        if (k <= qi) {
            const float mn = fmaxf(m, s), a = __expf(m - mn), p = __expf(s - mn);
            l = l * a + p; m = mn;
#pragma unroll
            for (int d = 0; d < 64; ++d) o[d] = o[d] * a + p * kp[64 + d];
        }
    }
    const float inv = 1.f / l;
#pragma unroll
    for (int d = 0; d < 64; ++d) mix[(size_t)t * 1024 + h * 64 + d] = o[d] * inv;
}

__global__ void __launch_bounds__(256) k_gdn_prep(const float* proj, const float* conv_w, const float* a_log, const float* dt_bias,
                                                   float* gq, float* gk, float* gv, float* gbeta, float* gla) {
    const int t = blockIdx.x, s = t % SEQ;
    __shared__ float buf[1536];
    for (int c = threadIdx.x; c < 1536; c += 256) {
        float acc = 0.f;
#pragma unroll
        for (int k = 0; k < 4; ++k) { const int ss = s - 3 + k; if (ss >= 0) acc += conv_w[k * 1536 + c] * proj[(size_t)(t - 3 + k) * HY_IN + MLA_COLS + c]; }
        buf[c] = silu_f(acc);
    }
    __syncthreads();
    const int w = threadIdx.x >> 6, lane = threadIdx.x & 63;
    for (int hh = w; hh < 16; hh += 4) {
        const float v = buf[hh * 64 + lane];
        float ss = v * v;
        for (int o = 32; o >= 1; o >>= 1) ss += __shfl_xor(ss, o);
        const float r = rsqrtf(ss + RMS_EPS);
        if (hh < 8) gq[(size_t)t * 512 + hh * 64 + lane] = v * r * 0.125f;
        else gk[(size_t)t * 512 + (hh - 8) * 64 + lane] = v * r;
    }
    for (int c = threadIdx.x; c < 512; c += 256) gv[(size_t)t * 512 + c] = buf[1024 + c];
    if (threadIdx.x < 8) {
        const int hh = threadIdx.x;
        const float a = proj[(size_t)t * HY_IN + MLA_COLS + 1536 + hh], bb = proj[(size_t)t * HY_IN + MLA_COLS + 1544 + hh];
        gbeta[(size_t)t * 8 + hh] = 1.f / (1.f + expf(-bb));
        const float z = a + dt_bias[hh];
        const float sp = (z > 20.f) ? z : log1pf(expf(z));
        gla[(size_t)t * 8 + hh] = -expf(a_log[hh]) * sp;
    }
}

__global__ void __launch_bounds__(64) k_gdn_rec(const float* gq, const float* gk, const float* gv, const float* gbeta, const float* gla,
                                                 const float* proj, const float* o_norm, float* mix) {
    const int h = blockIdx.x, b = blockIdx.y, dv = threadIdx.x;
    float S[64];
#pragma unroll
    for (int i = 0; i < 64; ++i) S[i] = 0.f;
    __shared__ float ks[64], qs[64];
    for (int s = 0; s < SEQ; ++s) {
        const int t = b * SEQ + s;
        ks[dv] = gk[(size_t)t * 512 + h * 64 + dv]; qs[dv] = gq[(size_t)t * 512 + h * 64 + dv];
        __syncthreads();
        const float alpha = expf(gla[(size_t)t * 8 + h]), beta = gbeta[(size_t)t * 8 + h];
        float r = 0.f;
#pragma unroll
        for (int i = 0; i < 64; ++i) r += ks[i] * S[i];
        const float vn = beta * (gv[(size_t)t * 512 + h * 64 + dv] - alpha * r);
        float o = 0.f;
#pragma unroll
        for (int i = 0; i < 64; ++i) { S[i] = alpha * S[i] + ks[i] * vn; o += qs[i] * S[i]; }
        float ss = o * o;
        for (int of = 32; of >= 1; of >>= 1) ss += __shfl_xor(ss, of);
        const float rn = rsqrtf(ss / 64.f + RMS_EPS);
        const float g = proj[(size_t)t * HY_IN + MLA_COLS + 1552 + h * 64 + dv];
        mix[(size_t)t * 1024 + 512 + h * 64 + dv] = o * rn * o_norm[dv] * silu_f(g);
        __syncthreads();
    }
}

__global__ void __launch_bounds__(256) k_ln(float* x, const float* y, const float* mod_lb, int which, const float* g, const float* bta,
                                             const float* Yp, const int* slot_of, const float* slot_w) {
    const int t = blockIdx.x * 4 + (threadIdx.x >> 6), lane = threadIdx.x & 63, b = t / SEQ;
    const float* gt = mod_lb + (size_t)b * 6 * D + which * 3 * D + 2 * D;
    float v[16], s = 0.f;
#pragma unroll
    for (int j = 0; j < 16; ++j) {
        const int d = lane + 64 * j;
        float yy;
        if (Yp) yy = slot_w[t * 2] * Yp[(size_t)slot_of[t * 2] * D + d] + slot_w[t * 2 + 1] * Yp[(size_t)slot_of[t * 2 + 1] * D + d];
        else yy = y[(size_t)t * D + d];
        v[j] = ALPHA * x[(size_t)t * D + d] + (1.f + gt[d]) * yy; s += v[j];
    }
    for (int o = 32; o >= 1; o >>= 1) s += __shfl_xor(s, o);
    const float mean = s / D; float q = 0.f;
#pragma unroll
    for (int j = 0; j < 16; ++j) { v[j] -= mean; q += v[j] * v[j]; }
    for (int o = 32; o >= 1; o >>= 1) q += __shfl_xor(q, o);
    const float rstd = rsqrtf(q / D + LN_EPS);
#pragma unroll
    for (int j = 0; j < 16; ++j) { const int d = lane + 64 * j; x[(size_t)t * D + d] = v[j] * rstd * g[d] + bta[d]; }
}

__global__ void k_ret_rope(float* proj, const int* positions) {
    const int idx = blockIdx.x * blockDim.x + threadIdx.x;
    if (idx >= T * 16 * 64) return;
    const int t = idx / 1024, r = idx % 1024, hh = r / 64, i = r % 64;
    const float pos = (float)positions[t];
    const float inv = powf(10000.f, -(float)(2 * i) / 128.f);
    const float ang = pos * inv, c = cosf(ang), s = sinf(ang);
    float* p = proj + (size_t)t * RET_IN + hh * 128;
    const float sc = (hh < 8) ? 0.08838834764831845f : 1.f;
    const float x1 = p[i], x2 = p[i + 64];
    p[i] = (x1 * c - x2 * s) * sc; p[i + 64] = (x1 * s + x2 * c) * sc;
}

__global__ void __launch_bounds__(256) k_ret_rec(const float* proj, float* o) {
    const int h = blockIdx.x, b = blockIdx.y, dv = threadIdx.x;
    const float gamma = 1.f - exp2f(-5.f - (float)h);
    float S[128];
#pragma unroll
    for (int i = 0; i < 128; ++i) S[i] = 0.f;
    __shared__ float ks[128], qs[128];
    for (int s = 0; s < SEQ; ++s) {
        const int t = b * SEQ + s;
        const float* p = proj + (size_t)t * RET_IN;
        if (dv < 128) { qs[dv] = p[h * 128 + dv]; ks[dv] = p[1024 + h * 128 + dv]; }
        __syncthreads();
        const float vv = p[2048 + h * 256 + dv];
        float acc = 0.f;
#pragma unroll
        for (int i = 0; i < 128; ++i) { S[i] = gamma * S[i] + ks[i] * vv; acc += qs[i] * S[i]; }
        o[(size_t)t * RET_MIX + h * 256 + dv] = acc;
        __syncthreads();
    }
}

__global__ void __launch_bounds__(256) k_ret_gn(float* o, const float* proj, const float* gn_g, const float* gn_b) {
    const int wid = blockIdx.x * 4 + (threadIdx.x >> 6), lane = threadIdx.x & 63;
    const int t = wid / 8, h = wid % 8;
    float* p = o + (size_t)t * RET_MIX + h * 256;
    float v[4], s = 0.f;
#pragma unroll
    for (int j = 0; j < 4; ++j) { v[j] = p[lane + 64 * j]; s += v[j]; }
    for (int of = 32; of >= 1; of >>= 1) s += __shfl_xor(s, of);
    const float mean = s / 256.f; float q = 0.f;
#pragma unroll
    for (int j = 0; j < 4; ++j) { v[j] -= mean; q += v[j] * v[j]; }
    for (int of = 32; of >= 1; of >>= 1) q += __shfl_xor(q, of);
    const float rstd = rsqrtf(q / 256.f + LN_EPS);
#pragma unroll
    for (int j = 0; j < 4; ++j) {
        const int c = h * 256 + lane + 64 * j;
        const float g = proj[(size_t)t * RET_IN + 4096 + c];
        p[lane + 64 * j] = silu_f(g) * (v[j] * rstd * gn_g[c] + gn_b[c]);
    }
}

__global__ void __launch_bounds__(256) k_router(const float* h, const float* wg, const float* bg, const float* we, const float* be,
                                                 int* slot_e, float* slot_w, int* slot_pos, int* cnt) {
    const int t = blockIdx.x * 4 + (threadIdx.x >> 6), lane = threadIdx.x & 63;
    float acc[36];
#pragma unroll
    for (int j = 0; j < 36; ++j) acc[j] = 0.f;
    for (int k = lane; k < D; k += 64) {
        const float xv = h[(size_t)t * D + k];
#pragma unroll
        for (int j = 0; j < 4; ++j) acc[j] += xv * wg[k * NG + j];
#pragma unroll
        for (int j = 0; j < 32; ++j) acc[4 + j] += xv * we[k * NE + j];
    }
#pragma unroll
    for (int j = 0; j < 36; ++j) for (int o = 32; o >= 1; o >>= 1) acc[j] += __shfl_xor(acc[j], o);
    if (lane == 0) {
        float gl[4];
#pragma unroll
        for (int j = 0; j < 4; ++j) { gl[j] = acc[j] + bg[j]; }
        int gi = 0; float gbest = gl[0];
#pragma unroll
        for (int j = 1; j < 4; ++j) if (gl[j] > gbest) { gbest = gl[j]; gi = j; }
        float den = 0.f;
#pragma unroll
        for (int j = 0; j < 4; ++j) den += expf(gl[j] - gbest);
        const float gtop = 1.f / den;
        float el[8];
#pragma unroll
        for (int j = 0; j < 8; ++j) { float v = 0.f;
#pragma unroll
            for (int g2 = 0; g2 < 4; ++g2) if (g2 == gi) v = acc[4 + g2 * 8 + j] + be[g2 * 8 + j];
            el[j] = v; }
        int i0 = 0; float b0 = el[0];
#pragma unroll
        for (int j = 1; j < 8; ++j) if (el[j] > b0) { b0 = el[j]; i0 = j; }
        int i1 = -1; float b1 = -3.4e38f;
#pragma unroll
        for (int j = 0; j < 8; ++j) if (j != i0 && el[j] > b1) { b1 = el[j]; i1 = j; }
        const float e1 = expf(b1 - b0);
        const float w0 = gtop / (1.f + e1), w1 = gtop * e1 / (1.f + e1);
        const int ex0 = gi * 8 + i0, ex1 = gi * 8 + i1;
        slot_e[t * 2] = ex0; slot_e[t * 2 + 1] = ex1; slot_w[t * 2] = w0; slot_w[t * 2 + 1] = w1;
        slot_pos[t * 2] = atomicAdd(&cnt[ex0], 1); slot_pos[t * 2 + 1] = atomicAdd(&cnt[ex1], 1);
    }
}

__global__ void __launch_bounds__(256) k_gather(const float* h, const int* slot_e, const int* slot_pos, const int* cnt, float* Xp, int* slot_of, int* tile_expert, int* n_tiles) {
    __shared__ int pstart[NE + 1];
    if (threadIdx.x == 0) { int a = 0; for (int e = 0; e < NE; ++e) { pstart[e] = a; a += (cnt[e] + 255) / 256 * 256; } pstart[NE] = a; }
    __syncthreads();
    if (blockIdx.x == 0) {
        if (threadIdx.x == 0) *n_tiles = pstart[NE] / 256;
        for (int i = threadIdx.x; i < XP_ROWS / 256; i += 256) { int e = 0; while (e < NE - 1 && i * 256 >= pstart[e + 1]) ++e; tile_expert[i] = e; }
    }
    const int sl = blockIdx.x * 4 + (threadIdx.x >> 6), lane = threadIdx.x & 63;
    const int t = sl >> 1;
    const int slot = pstart[slot_e[sl]] + slot_pos[sl];
    if (lane == 0) slot_of[sl] = slot;
    for (int d = lane; d < D; d += 64) Xp[(size_t)slot * D + d] = h[(size_t)t * D + d];
}

__global__ void k_silu_mul(float* G, const float* U, const int* n_tiles) {
    const size_t i = (size_t)blockIdx.x * blockDim.x + threadIdx.x;
    if (i >= (size_t)(*n_tiles) * 256 * FF) return;
    G[i] = silu_f(G[i]) * U[i];
}

__global__ void k_zero_int(int* p, int n) { const int i = blockIdx.x * blockDim.x + threadIdx.x; if (i < n) p[i] = 0; }
__global__ void k_copy(const float* a, float* b, size_t n) { const size_t i = (size_t)blockIdx.x * blockDim.x + threadIdx.x; if (i < n) b[i] = a[i]; }

void gemm(hipStream_t st, const float* A, int lda, const float* B, int ldb, float* C, int ldc, int M, int N, int K,
          const int* tile_expert = nullptr, size_t bstride = 0, const int* n_tiles = nullptr) {
    dim3 grid((N + 63) / 64, M / 64);
    hipLaunchKernelGGL(k_gemm, grid, dim3(256), 0, st, A, lda, B, ldb, C, ldc, M, N, K, tile_expert, bstride, n_tiles);
}
}

extern "C" void kernel_launch(void* const* d_in, const int* in_sizes, int n_in, void* d_out, int out_size, void* d_ws, size_t ws_size, hipStream_t stream) {
    if (ws_size < WS_END) { fprintf(stderr, "ws too small: %zu\n", ws_size); return; }
    const float* x_in = (const float*)d_in[0]; const float* c = (const float*)d_in[1]; const int* positions = (const int*)d_in[2];
    const float* ada_w = (const float*)d_in[3]; const float* ada_b = (const float*)d_in[4];
    const float* ln_mix_g = (const float*)d_in[5]; const float* ln_mix_b = (const float*)d_in[6];
    const float* ln_ffn_g = (const float*)d_in[7]; const float* ln_ffn_b = (const float*)d_in[8];
    const float* hy_w_in = (const float*)d_in[9]; const float* mla_q_norm = (const float*)d_in[10]; const float* mla_w_uq = (const float*)d_in[11];
    const float* mla_kv_norm = (const float*)d_in[12]; const float* mla_w_ukv = (const float*)d_in[13]; const float* gdn_conv_w = (const float*)d_in[14];
    const float* gdn_a_log = (const float*)d_in[15]; const float* gdn_dt_bias = (const float*)d_in[16]; const float* gdn_norm = (const float*)d_in[17];
    const float* hy_w_out = (const float*)d_in[18]; const float* ret_w_in = (const float*)d_in[19]; const float* ret_gn_g = (const float*)d_in[20];
    const float* ret_gn_b = (const float*)d_in[21]; const float* ret_w_out = (const float*)d_in[22]; const float* moe_w_group = (const float*)d_in[23];
    const float* moe_b_group = (const float*)d_in[24]; const float* moe_w_expert = (const float*)d_in[25]; const float* moe_b_expert = (const float*)d_in[26];
    const float* moe_w_gate = (const float*)d_in[27]; const float* moe_w_up = (const float*)d_in[28]; const float* moe_w_down = (const float*)d_in[29];
    char* ws = (char*)d_ws;
    float* x = (float*)d_out;
    int* ctl = (int*)(ws + WS_CTL);
    float* mod = (float*)(ws + WS_MOD);
    float* h = (float*)(ws + WS_H);
    float* y = (float*)(ws + WS_Y);
    float* proj = (float*)(ws + WS_R1);
    float* mix = (float*)(ws + WS_R2);
    float* qn = (float*)(ws + WS_R1 + 162 * MiB);
    float* kvn = qn + (size_t)T * 256;
    float* qf = kvn + (size_t)T * 128;
    float* kvf = qf + (size_t)T * 768;
    float* krope = kvf + (size_t)T * 1024;
    float* gq = (float*)(ws + WS_R2 + 64 * MiB);
    float* gk = gq + (size_t)T * 512; float* gv = gk + (size_t)T * 512; float* gbeta = gv + (size_t)T * 512; float* gla = gbeta + (size_t)T * 8;
    float* Xp = (float*)(ws + WS_R1); float* Gb = Xp + (size_t)XP_ROWS * D; float* Ub = Gb + (size_t)XP_ROWS * FF; float* Yp = (float*)(ws + WS_R2);
    int* cnt = ctl; int* n_tiles = ctl + 64; int* tile_expert = ctl + 128; int* slot_e = ctl + 1024; int* slot_pos = slot_e + 2 * T; int* slot_of = slot_pos + 2 * T;
    float* slot_w = (float*)(slot_of + 2 * T);

    const size_t nTD = (size_t)T * D;
    hipLaunchKernelGGL(k_copy, dim3((unsigned)((nTD + 255) / 256)), dim3(256), 0, stream, x_in, x, nTD);
    hipLaunchKernelGGL(k_mod, dim3(DEPTH * 6 * D / 256), dim3(256), 0, stream, c, ada_w, ada_b, mod);
    for (int layer = 0; layer < DEPTH; ++layer) {
        const float* mod_l = mod + (size_t)layer * NB * 6 * D;
        const int i = layer / 2;
        hipLaunchKernelGGL(k_modulate, dim3((unsigned)(nTD / 256)), dim3(256), 0, stream, x, mod_l, 0, h);
        if (layer % 2 == 0) {
            gemm(stream, h, D, hy_w_in + (size_t)i * D * HY_IN, HY_IN, proj, HY_IN, T, HY_IN, D);
            hipLaunchKernelGGL(k_mla_norm, dim3(T / 4), dim3(256), 0, stream, proj, mla_q_norm + i * 256, mla_kv_norm + i * 128, qn, kvn);
            gemm(stream, qn, 256, mla_w_uq + (size_t)i * 256 * 768, 768, qf, 768, T, 768, 256);
            gemm(stream, kvn, 128, mla_w_ukv + (size_t)i * 128 * 1024, 1024, kvf, 1024, T, 1024, 128);
            hipLaunchKernelGGL(k_mla_rope, dim3(T * 144 / 256), dim3(256), 0, stream, qf, proj, positions, krope);
            hipLaunchKernelGGL(k_attn, dim3(SEQ / 64, MLA_H, NB), dim3(64), 0, stream, qf, kvf, krope, mix);
            hipLaunchKernelGGL(k_gdn_prep, dim3(T), dim3(256), 0, stream, proj, gdn_conv_w + (size_t)i * 4 * 1536, gdn_a_log + i * 8, gdn_dt_bias + i * 8, gq, gk, gv, gbeta, gla);
            hipLaunchKernelGGL(k_gdn_rec, dim3(GDN_H, NB), dim3(64), 0, stream, gq, gk, gv, gbeta, gla, proj, gdn_norm + i * 64, mix);
            gemm(stream, mix, 1024, hy_w_out + (size_t)i * 1024 * D, D, y, D, T, D, 1024);
        } else {
            gemm(stream, h, D, ret_w_in + (size_t)i * D * RET_IN, RET_IN, proj, RET_IN, T, RET_IN, D);
            hipLaunchKernelGGL(k_ret_rope, dim3(T * 1024 / 256), dim3(256), 0, stream, proj, positions);
            hipLaunchKernelGGL(k_ret_rec, dim3(RET_H, NB), dim3(256), 0, stream, proj, mix);
            hipLaunchKernelGGL(k_ret_gn, dim3(T * 8 / 4), dim3(256), 0, stream, mix, proj, ret_gn_g + (size_t)i * RET_MIX, ret_gn_b + (size_t)i * RET_MIX);
            gemm(stream, mix, RET_MIX, ret_w_out + (size_t)i * RET_MIX * D, D, y, D, T, D, RET_MIX);
        }
        hipLaunchKernelGGL(k_ln, dim3(T / 4), dim3(256), 0, stream, x, y, mod_l, 0, ln_mix_g + layer * D, ln_mix_b + layer * D, (const float*)nullptr, (const int*)nullptr, (const float*)nullptr);
        hipLaunchKernelGGL(k_modulate, dim3((unsigned)(nTD / 256)), dim3(256), 0, stream, x, mod_l, 1, h);
        hipLaunchKernelGGL(k_zero_int, dim3(1), dim3(256), 0, stream, ctl, 256);
        hipLaunchKernelGGL(k_router, dim3(T / 4), dim3(256), 0, stream, h, moe_w_group + (size_t)layer * D * NG, moe_b_group + layer * NG,
                           moe_w_expert + (size_t)layer * D * NE, moe_b_expert + layer * NE, slot_e, slot_w, slot_pos, cnt);
        hipLaunchKernelGGL(k_gather, dim3(2 * T / 4), dim3(256), 0, stream, h, slot_e, slot_pos, cnt, Xp, slot_of, tile_expert, n_tiles);
        const size_t wstride = (size_t)D * FF;
        gemm(stream, Xp, D, moe_w_gate + (size_t)layer * NE * wstride, FF, Gb, FF, XP_ROWS, FF, D, tile_expert, wstride, n_tiles);
        gemm(stream, Xp, D, moe_w_up + (size_t)layer * NE * wstride, FF, Ub, FF, XP_ROWS, FF, D, tile_expert, wstride, n_tiles);
        hipLaunchKernelGGL(k_silu_mul, dim3((unsigned)((size_t)XP_ROWS * FF / 256)), dim3(256), 0, stream, Gb, Ub, n_tiles);
        gemm(stream, Gb, FF, moe_w_down + (size_t)layer * NE * wstride, D, Yp, D, XP_ROWS, D, FF, tile_expert, wstride, n_tiles);
        hipLaunchKernelGGL(k_ln, dim3(T / 4), dim3(256), 0, stream, x, (const float*)nullptr, mod_l, 1, ln_ffn_g + layer * D, ln_ffn_b + layer * D, Yp, slot_of, slot_w);
    }
}
```

```cpp
#include <hip/hip_runtime.h>
#include <cstdio>
#include <cstdint>
namespace pg8 {
#define PG8_LAS __attribute__((address_space(3)))
typedef unsigned short bf16_t;
typedef short bf16x8 __attribute__((ext_vector_type(8)));
typedef float f32x4 __attribute__((ext_vector_type(4)));
typedef unsigned u32x4 __attribute__((ext_vector_type(4)));
constexpr int BM = 256, BK = 64, HALF = 128, HTB = HALF * BK * 2  , STAGE_BYTES = 8 * HTB, NXCD = 8, WGM = 8;

__host__ __device__ __forceinline__ int lds_byte(int r, int c) { const int st = (r >> 4) * 2 + (c >> 5), rr = r & 15, cc = c & 31, ob = rr * 64 + cc * 2; return st * 1024 + (ob ^ (((ob >> 9) & 1) << 5)); }
__host__ __device__ __forceinline__ void stage_rc(int b, int& R, int& C) { const int st = b / 1024, sb = b % 1024, swz = sb ^ (((sb >> 9) & 1) << 5); R = (st >> 1) * 16 + swz / 64; C = (st & 1) * 32 + (swz % 64) / 2; }
__host__ __device__ __forceinline__ int perm32(int rho) { const int n = rho >> 4, i = rho & 15; return 8 * (i >> 2) + 4 * n + (i & 3); }

struct Unit { int pm, pn; };
struct Gemm { const bf16_t* A; const bf16_t* Bt; int M, N, K; };

struct StaticOrder {
    int nM, nN, nwg, G, c;
    __host__ __device__ void init(int M, int N, int G_, int c_) { nM = M / BM; nN = N / BM; nwg = nM * nN; G = G_; c = c_; }
    __host__ __device__ bool next(int i, Unit& u) const {
        const long L = (long)i * G + c; if (L >= nwg) return false;
        int wgid = (int)L; { const int q = nwg / NXCD, r = nwg % NXCD, xcd = wgid % NXCD, off = wgid / NXCD; wgid = (xcd < r ? xcd * (q + 1) : r * (q + 1) + (xcd - r) * q) + off; }
        const int nig = WGM * nN, gid = wgid / nig, fm = gid * WGM, gsz = (nM - fm) < WGM ? (nM - fm) : WGM;
        u.pm = fm + ((wgid % nig) % gsz); u.pn = (wgid % nig) / gsz; return true;
    }
    __device__ __forceinline__ void a_ready(const Unit&) const {}
    __device__ __forceinline__ void done(const Unit&) const {}
};

__device__ __forceinline__ unsigned cvt_pk_bf16(float lo, float hi) { unsigned r; asm volatile("v_cvt_pk_bf16_f32 %0, %1, %2" : "=v"(r) : "v"(lo), "v"(hi)); return r; }
typedef float f32x2 __attribute__((ext_vector_type(2)));
typedef unsigned u32x2 __attribute__((ext_vector_type(2)));
struct EpiF32 {
    static constexpr bool PERM = false, AFTER_DRAIN = false;
    float* C; int ldc; int pn_mask;
    __device__ __forceinline__ void operator()(const f32x4 (&acc)[2][2][4][2], const Unit& u, int wr, int wc, int fr, int fq) const {
        const int row0 = u.pm * BM + wr * 64 + fr, col0 = (u.pn & pn_mask) * BM + wc * 32 + 4 * fq;
#pragma unroll
        for (int ai = 0; ai < 2; ++ai)
#pragma unroll
            for (int m = 0; m < 4; ++m) { float* rowp = C + (size_t)(row0 + ai * HALF + m * 16) * ldc + col0;
#pragma unroll
                for (int bj = 0; bj < 2; ++bj)
#pragma unroll
                    for (int n = 0; n < 2; ++n) *(f32x4*)(rowp + bj * HALF + n * 16) = acc[ai][bj][m][n]; }
    }
};
struct EpiB16 {
    static constexpr bool PERM = false, AFTER_DRAIN = false;
    bf16_t* O; int ldc; int pn_mask;
    __device__ __forceinline__ void operator()(const f32x4 (&acc)[2][2][4][2], const Unit& u, int wr, int wc, int fr, int fq) const {
        const int row0 = u.pm * BM + wr * 64 + fr, col0 = (u.pn & pn_mask) * BM + wc * 32 + 4 * fq;
#pragma unroll
        for (int ai = 0; ai < 2; ++ai)
#pragma unroll
            for (int m = 0; m < 4; ++m) { bf16_t* rowp = O + (size_t)(row0 + ai * HALF + m * 16) * ldc + col0;
#pragma unroll
                for (int bj = 0; bj < 2; ++bj)
#pragma unroll
                    for (int n = 0; n < 2; ++n) { const f32x4 v = acc[ai][bj][m][n]; u32x2 w; w.x = cvt_pk_bf16(v[0], v[1]); w.y = cvt_pk_bf16(v[2], v[3]); *(u32x2*)(rowp + bj * HALF + n * 16) = w; } }
    }
};
struct EpiSiluMul {
    static constexpr bool PERM = false, AFTER_DRAIN = false;
    bf16_t* O; int ldc;
    __device__ __forceinline__ void operator()(const f32x4 (&acc)[2][2][4][2], const Unit& u, int wr, int wc, int fr, int fq) const {
        const int row0 = u.pm * BM + wr * 64 + fr, f0 = ((u.pn & 3) * 8 + wc) * 16 + 4 * fq;
#pragma unroll
        for (int ai = 0; ai < 2; ++ai)
#pragma unroll
            for (int m = 0; m < 4; ++m) { bf16_t* rowp = O + (size_t)(row0 + ai * HALF + m * 16) * ldc + f0;
#pragma unroll
                for (int bj = 0; bj < 2; ++bj) { const f32x4 g = acc[ai][bj][m][0], up = acc[ai][bj][m][1]; f32x4 r;
#pragma unroll
                    for (int j = 0; j < 4; ++j) r[j] = g[j] * __builtin_amdgcn_rcpf(1.f + __expf(-g[j])) * up[j];
                    u32x2 w; w.x = cvt_pk_bf16(r[0], r[1]); w.y = cvt_pk_bf16(r[2], r[3]); *(u32x2*)(rowp + bj * 64) = w; } }
    }
};
struct GroupedOrder {
    const int* tile_expert; int n_units, G, c;
    __device__ bool next(int i, Unit& u) const { const int L = i * G + c; if (L >= n_units) return false; const int rt = L >> 2; u.pm = rt; u.pn = tile_expert[rt] * 4 + (L & 3); return true; }
    __device__ __forceinline__ void a_ready(const Unit&) const {}
    __device__ __forceinline__ void done(const Unit&) const {}
};
template <class Epi, class Sched, bool ALIGN_EPI = false, bool SP2 = false>
__device__ __forceinline__ void gemm_phase(PG8_LAS unsigned char* lds, const Gemm g, const Sched& S, const Epi& E) {
    int tid_ = threadIdx.x; asm volatile("" : "+v"(tid_));
    const int tid = tid_, wid = __builtin_amdgcn_readfirstlane(tid >> 6), lane = tid & 63, wr = wid >> 2, wc = wid & 3, fr = lane & 15, fq = lane >> 4;
    int K_ = g.K; asm volatile("" : "+s"(K_));
    const int K = K_, nt = K / BK;
    unsigned voffA[2], voffB[2];
#pragma unroll
    for (int i = 0; i < 2; ++i) { int R, C; stage_rc(tid * 16 + i * 8192, R, C); const int Rb = Epi::PERM ? ((R & ~31) + perm32(R & 31)) : R;
        voffA[i] = (unsigned)(R * K + C) * 2u; voffB[i] = (unsigned)(Rb * K + C) * 2u; }
    const size_t kstep = (size_t)(BK * 2);
    const size_t hstep = (size_t)HALF * K * 2;
    const size_t tstep = 2 * hstep;
    const unsigned ldsw = (unsigned)wid * 1024u;
    const int aoff = lds_byte(wr * 64 + fr, fq * 8), boff = lds_byte(wc * 32 + fr, fq * 8);
#define PG8_SA(b, h) (((b) * 2 + (h)) * HTB)
#define PG8_SB(b, h) ((4 + (b) * 2 + (h)) * HTB)
#define PG8_STAGE(bufoff, gbase, voff) do { _Pragma("unroll") for (int _i = 0; _i < 2; ++_i) \
        __builtin_amdgcn_global_load_lds((const unsigned*)((const char*)(gbase) + (voff)[_i]), (PG8_LAS unsigned*)(lds + (bufoff) + ldsw + _i * 8192), 16, 0, 0); } while (0)
#define PG8_LDA(dst, b, h) do { _Pragma("unroll") for (int m = 0; m < 4; ++m) _Pragma("unroll") for (int k = 0; k < 2; ++k) dst[m][k] = *(const PG8_LAS bf16x8*)(lds + PG8_SA(b, h) + aoff + m * 2048 + k * 1024); } while (0)
#define PG8_LDB(dst, b, h) do { _Pragma("unroll") for (int n = 0; n < 2; ++n) _Pragma("unroll") for (int k = 0; k < 2; ++k) dst[n][k] = *(const PG8_LAS bf16x8*)(lds + PG8_SB(b, h) + boff + n * 2048 + k * 1024); } while (0)
#define PG8_MMA(ai, bj, At, Bt) do { __builtin_amdgcn_s_setprio(1); _Pragma("unroll") for (int m = 0; m < 4; ++m) _Pragma("unroll") for (int n = 0; n < 2; ++n) _Pragma("unroll") for (int k = 0; k < 2; ++k) \
        acc[ai][bj][m][n] = __builtin_amdgcn_mfma_f32_16x16x32_bf16(Bt[n][k], At[m][k], acc[ai][bj][m][n], 0, 0, 0); __builtin_amdgcn_s_setprio(0); } while (0)
#define PG8_WAIT_V(n) asm volatile("s_waitcnt vmcnt(" #n ")" ::: "memory")
#define PG8_WAIT_L(n) asm volatile("s_waitcnt lgkmcnt(" #n ")" ::: "memory")
#define PG8_BAR __builtin_amdgcn_s_barrier()
#define PG8_SCHED __builtin_amdgcn_sched_barrier(0)
    Unit cur, nxt; int ui = 0;
    if (!S.next(0, cur)) return;
    f32x4 acc[2][2][4][2];
#pragma unroll
    for (int a = 0; a < 2; ++a)
#pragma unroll
        for (int b = 0; b < 2; ++b)
#pragma unroll
            for (int m = 0; m < 4; ++m)
#pragma unroll
                for (int n = 0; n < 2; ++n) acc[a][b][m][n] = (f32x4){0.f, 0.f, 0.f, 0.f};
    bf16x8 At[4][2], B0[2][2], B1[2][2];
    const char* cA = (const char*)g.A + (size_t)cur.pm * tstep; const char* cB = (const char*)g.Bt + (size_t)cur.pn * tstep;
    S.a_ready(cur);
    if constexpr (SP2) {
        PG8_STAGE(PG8_SB(0, 0), cB, voffB); PG8_STAGE(PG8_SB(0, 1), cB + hstep, voffB); PG8_STAGE(PG8_SA(0, 0), cA, voffA); PG8_STAGE(PG8_SA(0, 1), cA + hstep, voffA);
        if (wr == 1) PG8_BAR;
        PG8_WAIT_V(2); PG8_BAR;
        PG8_STAGE(PG8_SB(1, 0), cB + kstep, voffB); PG8_STAGE(PG8_SA(1, 0), cA + kstep, voffA); PG8_STAGE(PG8_SB(1, 1), cB + hstep + kstep, voffB);
        PG8_WAIT_V(6); PG8_BAR;
    } else {
        PG8_STAGE(PG8_SB(0, 0), cB, voffB); PG8_STAGE(PG8_SA(0, 0), cA, voffA); PG8_STAGE(PG8_SB(0, 1), cB + hstep, voffB); PG8_STAGE(PG8_SA(0, 1), cA + hstep, voffA);
        if (wr == 1) PG8_BAR;
        PG8_WAIT_V(4); PG8_BAR;
        PG8_STAGE(PG8_SB(1, 0), cB + kstep, voffB); PG8_STAGE(PG8_SA(1, 0), cA + kstep, voffA); PG8_STAGE(PG8_SB(1, 1), cB + hstep + kstep, voffB);
        PG8_WAIT_V(6); PG8_BAR;
    }
    for (;;) {
        const bool has_next = S.next(ui + 1, nxt);
        const char* nA = has_next ? (const char*)g.A + (size_t)nxt.pm * tstep : cA; const char* nB = has_next ? (const char*)g.Bt + (size_t)nxt.pn * tstep : cB;
        for (int t = 0; t < nt; t += 2) {
            const bool last = (t == nt - 2);
            const char* a1 = cA + (size_t)(t + 1) * kstep;
            const char* a2 = last ? nA : cA + (size_t)(t + 2) * kstep; const char* b2 = last ? nB : cB + (size_t)(t + 2) * kstep;
            const char* a3 = a2 + kstep; const char* b3 = b2 + kstep;
            if (last && has_next) S.a_ready(nxt);
            if constexpr (SP2) {
            PG8_LDB(B0, 0, 0); PG8_LDB(B1, 0, 1); PG8_SCHED; PG8_LDA(At, 0, 0); PG8_STAGE(PG8_SA(1, 1), a1 + hstep, voffA);
            PG8_WAIT_V(8); PG8_WAIT_L(0); PG8_BAR; PG8_MMA(0, 0, At, B0); PG8_MMA(0, 1, At, B1); PG8_BAR; PG8_SCHED;
            PG8_LDA(At, 0, 1); PG8_STAGE(PG8_SB(0, 0), b2, voffB); PG8_STAGE(PG8_SB(0, 1), b2 + hstep, voffB); PG8_STAGE(PG8_SA(0, 0), a2, voffA);
            PG8_WAIT_V(8); PG8_WAIT_L(0); PG8_BAR; PG8_MMA(1, 0, At, B0); PG8_MMA(1, 1, At, B1); PG8_BAR; PG8_SCHED;
            PG8_LDB(B0, 1, 0); PG8_LDB(B1, 1, 1); PG8_SCHED; PG8_LDA(At, 1, 0); PG8_STAGE(PG8_SA(0, 1), a2 + hstep, voffA);
            PG8_WAIT_V(8); PG8_WAIT_L(0); PG8_BAR; PG8_MMA(0, 0, At, B0); PG8_MMA(0, 1, At, B1); PG8_BAR; PG8_SCHED;
            PG8_LDA(At, 1, 1); PG8_STAGE(PG8_SB(1, 0), b3, voffB); PG8_STAGE(PG8_SB(1, 1), b3 + hstep, voffB); PG8_STAGE(PG8_SA(1, 0), a3, voffA);
            PG8_WAIT_V(8); PG8_WAIT_L(0); PG8_BAR; PG8_MMA(1, 0, At, B0); PG8_MMA(1, 1, At, B1); PG8_BAR; PG8_SCHED;
            } else {
            PG8_LDB(B0, 0, 0); PG8_SCHED; PG8_LDA(At, 0, 0); PG8_STAGE(PG8_SA(1, 1), a1 + hstep, voffA);
            PG8_WAIT_L(8); PG8_BAR; PG8_WAIT_L(0); PG8_MMA(0, 0, At, B0); PG8_BAR; PG8_SCHED;
            PG8_LDB(B1, 0, 1); PG8_STAGE(PG8_SB(0, 0), b2, voffB);
            PG8_BAR; PG8_WAIT_L(0); PG8_MMA(0, 1, At, B1); PG8_BAR;
            PG8_LDA(At, 0, 1); PG8_STAGE(PG8_SA(0, 0), a2, voffA);
            PG8_BAR; PG8_WAIT_L(0); PG8_MMA(1, 0, At, B0); PG8_BAR; PG8_SCHED;
            PG8_STAGE(PG8_SB(0, 1), b2 + hstep, voffB);
            PG8_WAIT_V(6); PG8_BAR; PG8_MMA(1, 1, At, B1); PG8_BAR;
            PG8_LDB(B0, 1, 0); PG8_SCHED; PG8_LDA(At, 1, 0); PG8_STAGE(PG8_SA(0, 1), a2 + hstep, voffA);
            PG8_WAIT_L(8); PG8_BAR; PG8_WAIT_L(0); PG8_MMA(0, 0, At, B0); PG8_BAR; PG8_SCHED;
            PG8_LDB(B1, 1, 1); PG8_STAGE(PG8_SB(1, 0), b3, voffB);
            PG8_BAR; PG8_WAIT_L(0); PG8_MMA(0, 1, At, B1); PG8_BAR;
            PG8_LDA(At, 1, 1); PG8_STAGE(PG8_SA(1, 0), a3, voffA);
            PG8_BAR; PG8_WAIT_L(0); PG8_MMA(1, 0, At, B0); PG8_BAR; PG8_SCHED;
            PG8_STAGE(PG8_SB(1, 1), b3 + hstep, voffB);
            PG8_WAIT_V(6); PG8_BAR; PG8_MMA(1, 1, At, B1); PG8_BAR;
            }
        }
        if constexpr (ALIGN_EPI) { if (wr == 0) PG8_BAR; }
        if constexpr (!Epi::AFTER_DRAIN) { E(acc, cur, wr, wc, fr, fq); S.done(cur); }
        if (!has_next) break;
#pragma unroll
        for (int a = 0; a < 2; ++a)
#pragma unroll
            for (int b = 0; b < 2; ++b)
#pragma unroll
                for (int m = 0; m < 4; ++m)
#pragma unroll
                    for (int n = 0; n < 2; ++n) acc[a][b][m][n] = (f32x4){0.f, 0.f, 0.f, 0.f};
        cur = nxt; cA = nA; cB = nB; ++ui;
        if constexpr (ALIGN_EPI) { if (wr == 1) PG8_BAR; }
    }
    PG8_WAIT_V(0);
    if constexpr (!ALIGN_EPI) { if (wr == 0) PG8_BAR; }
    PG8_BAR;
    if constexpr (Epi::AFTER_DRAIN) { E.fused(acc, cur, wr, wc, fr, fq, lds, wid, lane); S.done(cur); }
#undef PG8_SA
#undef PG8_SB
#undef PG8_STAGE
#undef PG8_LDA
#undef PG8_LDB
#undef PG8_MMA
#undef PG8_WAIT_V
#undef PG8_WAIT_L
#undef PG8_BAR
#undef PG8_SCHED
}
}
#define PG8_SP2 true
#define PG8_ALIGN true
#define GAS __attribute__((address_space(1)))
#define LAS __attribute__((address_space(3)))
typedef unsigned short bf16;
typedef unsigned v4u __attribute__((ext_vector_type(4)));
typedef float f32x4 __attribute__((ext_vector_type(4)));
typedef short bf16x8 __attribute__((ext_vector_type(8)));
typedef GAS unsigned gu32;
typedef GAS unsigned long long gu64;
#define RLX_AGENT __ATOMIC_RELAXED, __HIP_MEMORY_SCOPE_AGENT
#define LDS_WAIT() asm volatile("s_waitcnt lgkmcnt(0)" ::: "memory")
#define VM_WAIT() asm volatile("s_waitcnt vmcnt(0)" ::: "memory")
__device__ __forceinline__ unsigned long long rt() { return __builtin_amdgcn_s_memrealtime(); }
__device__ __forceinline__ unsigned f2bf(float f) { unsigned u = __builtin_bit_cast(unsigned, f); return (u + 0x7fffu + ((u >> 16) & 1u)) >> 16; }
__device__ __forceinline__ unsigned pk2(float lo, float hi) { return f2bf(lo) | (f2bf(hi) << 16); }

#define XB_TMO      128
#define XB_XCNT(j)  (256  + 64 * (j))
#define XB_XSUB(j)  (1280 + 64 * (j))
#define XB_XGEN(j)  (2304 + 64 * (j))
#define XB_TOP      3328
#define XB_TOPGEN   3392
#define XCD_BAR_WORDS 3456
#define XB_SPIN_CAP (1u << 18)

__device__ __forceinline__ unsigned xb_ld(unsigned* p)              { return __hip_atomic_load(p, __ATOMIC_RELAXED, __HIP_MEMORY_SCOPE_AGENT); }
__device__ __forceinline__ unsigned xb_add(unsigned* p, unsigned v) { return __hip_atomic_fetch_add(p, v, __ATOMIC_RELAXED, __HIP_MEMORY_SCOPE_AGENT); }
__device__ __forceinline__ unsigned xb_xcc_id() { return (unsigned)__builtin_amdgcn_s_getreg((3 << 11) | 20) & 0xFu; }
#define XB_SPIN(cond, bar) do { unsigned _sp = 0; while (cond) { __builtin_amdgcn_s_sleep(1); \
    if ((++_sp & 255u) == 0u) { if (xb_ld(&(bar)[XB_TMO])) break; if (_sp > XB_SPIN_CAP) { atomicAdd(&(bar)[XB_TMO], 1u); break; } } } } while (0)

struct XcdBarrier {
    unsigned* bar; unsigned x;
    volatile LAS unsigned* st;
};

__device__ __forceinline__ XcdBarrier xcd_barrier_post(unsigned* bar, volatile LAS unsigned* st) {
    XcdBarrier b; b.bar = bar; b.x = xb_xcc_id(); b.st = st;
    if (threadIdx.x == 0) (void)xb_add(&bar[XB_XCNT(b.x)], 1u);
    return b;
}
__device__ __forceinline__ void xcd_barrier_complete(unsigned* bar, unsigned x, unsigned& nloc, unsigned& nx) {
    const unsigned G = gridDim.x * gridDim.y * gridDim.z;
    unsigned sum, cnt, mine, sp = 0u;
    for (;;) {
        sum = 0u; cnt = 0u; mine = 0u;
#pragma unroll
        for (unsigned j = 0; j < 16; ++j) { const unsigned c = xb_ld(&bar[XB_XCNT(j)]); sum += c; cnt += (c > 0u) ? 1u : 0u; mine = (j == x) ? c : mine; }
        if (sum == G) break;
        __builtin_amdgcn_s_sleep(1);
        if ((++sp & 255u) == 0u) { if (xb_ld(&bar[XB_TMO])) break; if (sp > XB_SPIN_CAP) { atomicAdd(&bar[XB_TMO], 1u); break; } }
    }
    nloc = mine > 0u ? mine : 1u; nx = cnt > 0u ? cnt : 1u;
}

__device__ __forceinline__ void xcd_barrier(const XcdBarrier& b) {
    asm volatile("s_waitcnt vmcnt(0)" ::: "memory");
    __syncthreads();
    if (threadIdx.x == 0) {
        unsigned* bar = b.bar;
        __builtin_amdgcn_s_waitcnt(0);
        unsigned nloc = b.st[0], nx = b.st[1];
        if (nloc == 0u) { xcd_barrier_complete(bar, b.x, nloc, nx); b.st[0] = nloc; b.st[1] = nx; }
        const unsigned old = xb_add(&bar[XB_XSUB(b.x)], 1u);
        const unsigned gen = old / nloc;
        if (old + 1u == (gen + 1u) * nloc) {
            __builtin_amdgcn_fence(__ATOMIC_RELEASE, "agent");
            asm volatile("s_waitcnt vmcnt(0)" ::: "memory");
            const unsigned og = xb_add(&bar[XB_TOP], 1u);
            const unsigned tg = og / nx;
            if (og + 1u == (tg + 1u) * nx) xb_add(&bar[XB_TOPGEN], 1u);
            else XB_SPIN(xb_ld(&bar[XB_TOPGEN]) == tg, bar);
            __builtin_amdgcn_fence(__ATOMIC_ACQUIRE, "agent");
            xb_add(&bar[XB_XGEN(b.x)], 1u);
            asm volatile("s_waitcnt vmcnt(0)" ::: "memory");
        } else {
            XB_SPIN(xb_ld(&bar[XB_XGEN(b.x)]) == gen, bar);
            __builtin_amdgcn_fence(__ATOMIC_ACQUIRE, "agent");
            asm volatile("s_waitcnt vmcnt(0)" ::: "memory");
        }
    }
    __syncthreads();
}

namespace {
constexpr int D = 1024, NB = 4, SEQ = 4096, T = NB * SEQ, DEPTH = 4;
constexpr int MLA_COLS = 416, HY_IN = 2480, HY_LD = 2560, UP_K = 384, UP_N = 1792;
constexpr int RET_IN = 6144, RET_MIX = 2048;
constexpr int NG = 4, NE = 32, FF = 512;
constexpr int XP_ROWS = 2 * T + NE * 256;
constexpr float LN_EPS = 1e-5f, RMS_EPS = 1e-6f;
constexpr float ALPHA = 1.681792830507429f;
constexpr size_t MiB = 1u << 20;
constexpr size_t WS_CTL = 0, CTL_ZERO_BYTES = 1 * MiB;
constexpr size_t WS_MOD = 1 * MiB, WS_TAB = 1 * MiB + 512 * 1024;
constexpr size_t WS_HB = 2 * MiB, WS_Y = 34 * MiB;
constexpr size_t WS_WIN = 98 * MiB, WS_WUP = 108 * MiB, WS_WOUT = 111 * MiB, WS_RIN = 115 * MiB, WS_ROUT = 139 * MiB, WS_WGU = 147 * MiB, WS_WD = 403 * MiB;
constexpr size_t WS_R1 = 531 * MiB, WS_R2 = 723 * MiB, WS_END = 883 * MiB;
constexpr size_t WS_UPA = WS_R1 + 80 * MiB, WS_QUK = WS_R1 + 92 * MiB, WS_KR = WS_R1 + 150 * MiB, WS_HID = WS_R1 + 80 * MiB, WS_ST = WS_R2 + 64 * MiB, WS_GD = WS_R2 + 32 * MiB, WS_GL = WS_R2 + 112 * MiB;
constexpr int CW_TMO = 0, CW_CODE = 1, CW_CNT = 64, CW_NTILES = 128, CW_TEXP = 192  , CW_AQ = 512, CW_BAR = 4096;
constexpr int RING_OFF = 0, RING_BYTES = 131072, LDSCTL_OFF = RING_BYTES, MISC_OFF = LDSCTL_OFF + 320, LDS_BYTES = 147456;
constexpr int NWAVES = 8;

__device__ __forceinline__ float silu_f(float x) { return x / (1.f + __expf(-x)); }
__device__ __forceinline__ float bf2f(bf16 v) { return __uint_as_float(((unsigned)v) << 16); }
__device__ __forceinline__ bf16 f2b(float f) { return (bf16)f2bf(f); }

__global__ void k_mod(const float* c, const float* ada_w, const float* ada_b, float* mod) {
    const int idx = blockIdx.x * blockDim.x + threadIdx.x;
    if (idx >= DEPTH * 6 * D) return;
    const int l = idx / (6 * D), n = idx % (6 * D);
    float acc[NB] = {0.f, 0.f, 0.f, 0.f};
    const float* w = ada_w + (size_t)l * D * 6 * D + n;
    for (int k = 0; k < D; ++k) {
        const float wv = w[(size_t)k * 6 * D];
#pragma unroll
        for (int b = 0; b < NB; ++b) acc[b] += silu_f(c[b * D + k]) * wv;
    }
#pragma unroll
    for (int b = 0; b < NB; ++b) mod[((size_t)l * NB + b) * 6 * D + n] = acc[b] + ada_b[l * 6 * D + n];
}
__global__ void k_modulate(const float* x, const float* mod_lb, int which, bf16* hb) {
    const size_t i = (size_t)blockIdx.x * blockDim.x + threadIdx.x;
    if (i >= (size_t)T * D) return;
    const int t = (int)(i / D), d = (int)(i % D), b = t / SEQ;
    const float* m = mod_lb + (size_t)b * 6 * D + which * 3 * D;
    hb[i] = f2b(x[i] * (1.f + m[D + d]) + m[d]);
}
__global__ void k_mla_norm(const bf16* proj, bf16* upA) {
    const int t = blockIdx.x * 4 + (threadIdx.x >> 6), lane = threadIdx.x & 63;
    const bf16* p = proj + (size_t)t * HY_LD;
    float v[4], s = 0.f;
#pragma unroll
    for (int j = 0; j < 4; ++j) { v[j] = bf2f(p[lane + 64 * j]); s += v[j] * v[j]; }
    for (int o = 32; o >= 1; o >>= 1) s += __shfl_xor(s, o);
    const float r = rsqrtf(s / 256.f + RMS_EPS);
#pragma unroll
    for (int j = 0; j < 4; ++j) upA[(size_t)t * UP_K + lane + 64 * j] = f2b(v[j] * r);
    float w[2], s2 = 0.f;
#pragma unroll
    for (int j = 0; j < 2; ++j) { w[j] = bf2f(p[256 + lane + 64 * j]); s2 += w[j] * w[j]; }
    for (int o = 32; o >= 1; o >>= 1) s2 += __shfl_xor(s2, o);
    const float r2 = rsqrtf(s2 / 128.f + RMS_EPS);
#pragma unroll
    for (int j = 0; j < 2; ++j) upA[(size_t)t * UP_K + 256 + lane + 64 * j] = f2b(w[j] * r2);
}
__global__ void k_mla_rope(bf16* quk, const bf16* proj, const int* positions, bf16* Kr) {
    const int idx = blockIdx.x * blockDim.x + threadIdx.x;
    if (idx >= T * 9 * 16) return;
    const int t = idx / 144, r = idx % 144, hh = r / 16, i = r % 16;
    const float pos = (float)positions[t];
    const float inv = powf(10000.f, -(float)(2 * i) / 32.f);
    const float ang = pos * inv, c = cosf(ang), s = sinf(ang);
    const float QS = 0.14724270f;
    if (hh < 8) {
        bf16* q = quk + (size_t)t * UP_N + hh * 96;
        const float x1 = bf2f(q[64 + i]), x2 = bf2f(q[64 + i + 16]);
        q[64 + i] = f2b((x1 * c - x2 * s) * QS); q[64 + i + 16] = f2b((x1 * s + x2 * c) * QS);
#pragma unroll
        for (int j = 0; j < 4; ++j) q[4 * i + j] = f2b(bf2f(q[4 * i + j]) * QS);
    } else {
        const bf16* k = proj + (size_t)t * HY_LD + 384;
        const float x1 = bf2f(k[i]), x2 = bf2f(k[i + 16]);
        Kr[(size_t)t * 32 + i] = f2b(x1 * c - x2 * s); Kr[(size_t)t * 32 + i + 16] = f2b(x1 * s + x2 * c);
    }
}
__global__ void __launch_bounds__(256) k_ln(float* x, const float* y, const float* mod_lb, int which, const float* g, const float* bta,
                                             const float* Yp, const int* slot_of, const float* slot_w) {
    const int t = blockIdx.x * 4 + (threadIdx.x >> 6), lane = threadIdx.x & 63, b = t / SEQ;
    const float* gt = mod_lb + (size_t)b * 6 * D + which * 3 * D + 2 * D;
    float v[16], s = 0.f;
#pragma unroll
    for (int j = 0; j < 16; ++j) {
        const int d = lane + 64 * j;
        float yy;
        if (Yp) yy = slot_w[t * 2] * Yp[(size_t)slot_of[t * 2] * D + d] + slot_w[t * 2 + 1] * Yp[(size_t)slot_of[t * 2 + 1] * D + d];
        else yy = y[(size_t)t * D + d];
        v[j] = ALPHA * x[(size_t)t * D + d] + (1.f + gt[d]) * yy; s += v[j];
    }
    for (int o = 32; o >= 1; o >>= 1) s += __shfl_xor(s, o);
    const float mean = s / D; float q = 0.f;
#pragma unroll
    for (int j = 0; j < 16; ++j) { v[j] -= mean; q += v[j] * v[j]; }
    for (int o = 32; o >= 1; o >>= 1) q += __shfl_xor(q, o);
    const float rstd = rsqrtf(q / D + LN_EPS);
#pragma unroll
    for (int j = 0; j < 16; ++j) { const int d = lane + 64 * j; x[(size_t)t * D + d] = v[j] * rstd * g[d] + bta[d]; }
}
__global__ void k_ret_rope(bf16* proj, const int* positions) {
    const int idx = blockIdx.x * blockDim.x + threadIdx.x;
    if (idx >= T * 16 * 64) return;
    const int t = idx / 1024, r = idx % 1024, hh = r / 64, i = r % 64;
    const float pos = (float)positions[t];
    const float inv = powf(10000.f, -(float)(2 * i) / 128.f);
    const float ang = pos * inv, c = cosf(ang), s = sinf(ang);
    bf16* p = proj + (size_t)t * RET_IN + hh * 128;
    const float sc = (hh < 8) ? 0.08838834764831845f : 1.f;
    const float x1 = bf2f(p[i]), x2 = bf2f(p[i + 64]);
    p[i] = f2b((x1 * c - x2 * s) * sc); p[i + 64] = f2b((x1 * s + x2 * c) * sc);
}
__global__ void __launch_bounds__(256) k_router(const float* x, const float* mod_lb, const float* wg, const float* bg, const float* we, const float* be,
                                                 int* slot_e, float* slot_w, int* slot_pos, int* cnt) {
    const int t = blockIdx.x * 4 + (threadIdx.x >> 6), lane = threadIdx.x & 63, b = t / SEQ;
    const float* m = mod_lb + (size_t)b * 6 * D + 3 * D;
    float acc[36];
#pragma unroll
    for (int j = 0; j < 36; ++j) acc[j] = 0.f;
    for (int k = lane; k < D; k += 64) {
        const float xv = x[(size_t)t * D + k] * (1.f + m[D + k]) + m[k];
#pragma unroll
        for (int j = 0; j < 4; ++j) acc[j] += xv * wg[k * NG + j];
#pragma unroll
        for (int j = 0; j < 32; ++j) acc[4 + j] += xv * we[k * NE + j];
    }
#pragma unroll
    for (int j = 0; j < 36; ++j) for (int o = 32; o >= 1; o >>= 1) acc[j] += __shfl_xor(acc[j], o);
    if (lane == 0) {
        float gl[4];
#pragma unroll
        for (int j = 0; j < 4; ++j) { gl[j] = acc[j] + bg[j]; }
        int gi = 0; float gbest = gl[0];
#pragma unroll
        for (int j = 1; j < 4; ++j) if (gl[j] > gbest) { gbest = gl[j]; gi = j; }
        float den = 0.f;
#pragma unroll
        for (int j = 0; j < 4; ++j) den += expf(gl[j] - gbest);
        const float gtop = 1.f / den;
        float el[8];
#pragma unroll
        for (int j = 0; j < 8; ++j) { float v = 0.f;
#pragma unroll
            for (int g2 = 0; g2 < 4; ++g2) if (g2 == gi) v = acc[4 + g2 * 8 + j] + be[g2 * 8 + j];
            el[j] = v; }
        int i0 = 0; float b0 = el[0];
#pragma unroll
        for (int j = 1; j < 8; ++j) if (el[j] > b0) { b0 = el[j]; i0 = j; }
        int i1 = -1; float b1 = -3.4e38f;
#pragma unroll
        for (int j = 0; j < 8; ++j) if (j != i0 && el[j] > b1) { b1 = el[j]; i1 = j; }
        const float e1 = expf(b1 - b0);
        const float w0 = gtop / (1.f + e1), w1 = gtop * e1 / (1.f + e1);
        const int ex0 = gi * 8 + i0, ex1 = gi * 8 + i1;
        slot_e[t * 2] = ex0; slot_e[t * 2 + 1] = ex1; slot_w[t * 2] = w0; slot_w[t * 2 + 1] = w1;
        slot_pos[t * 2] = atomicAdd(&cnt[ex0], 1); slot_pos[t * 2 + 1] = atomicAdd(&cnt[ex1], 1);
    }
}
__global__ void __launch_bounds__(256) k_gather(const bf16* hb, const int* slot_e, const int* slot_pos, const int* cnt, bf16* Xp, int* slot_of, int* tile_expert, int* n_tiles) {
    __shared__ int pstart[NE + 1];
    if (threadIdx.x == 0) { int a = 0; for (int e = 0; e < NE; ++e) { pstart[e] = a; a += (cnt[e] + 255) / 256 * 256; } pstart[NE] = a; }
    __syncthreads();
    if (blockIdx.x == 0) {
        if (threadIdx.x == 0) *n_tiles = pstart[NE] / 256;
        for (int i = threadIdx.x; i < XP_ROWS / 256; i += 256) { int e = 0; while (e < NE - 1 && i * 256 >= pstart[e + 1]) ++e; tile_expert[i] = e; }
    }
    const int sl = blockIdx.x * 4 + (threadIdx.x >> 6), lane = threadIdx.x & 63;
    const int t = sl >> 1;
    const int slot = pstart[slot_e[sl]] + slot_pos[sl];
    if (lane == 0) slot_of[sl] = slot;
    const v4u* src = (const v4u*)(hb + (size_t)t * D); v4u* dst = (v4u*)(Xp + (size_t)slot * D);
    dst[lane] = src[lane]; dst[lane + 64] = src[lane + 64];
}
__global__ void k_zero_int(int* p, int n) { const int i = blockIdx.x * blockDim.x + threadIdx.x; if (i < n) p[i] = 0; }
__global__ void k_copy(const float* a, float* b, size_t n) { const size_t i = (size_t)blockIdx.x * blockDim.x + threadIdx.x; if (i < n) b[i] = a[i]; }

struct Args { const float* in[30]; float* out; unsigned char* ws; int ph_lo, ph_hi, li, pad; };
struct Frame {
    LAS unsigned char* lds; volatile LAS unsigned* MISC; gu32* ctl;
    int tid, lane, wave, vcu, G;
};
template <class F> __device__ __forceinline__ void tr_item(F src, int K, bf16* WT, int k0, int n0, LAS float* scr, int lane) {
#pragma unroll 8
    for (int i = 0; i < 32; ++i) { const int kk = 2 * i + (lane >> 5); scr[kk * 33 + (lane & 31)] = src(n0 + (lane & 31), k0 + kk); }
    LDS_WAIT(); asm volatile("" ::: "memory");
    const int c = lane & 7;
#pragma unroll
    for (int j = 0; j < 4; ++j) { const int n = (lane >> 3) + 8 * j; const LAS float* s = scr + (8 * c) * 33 + n;
        v4u o; o.x = pk2(s[0 * 33], s[1 * 33]); o.y = pk2(s[2 * 33], s[3 * 33]); o.z = pk2(s[4 * 33], s[5 * 33]); o.w = pk2(s[6 * 33], s[7 * 33]);
        *(GAS v4u*)(WT + (size_t)(n0 + n) * K + k0 + 8 * c) = o; }
    LDS_WAIT(); asm volatile("" ::: "memory");
}
__device__ __forceinline__ void p0_weights(Frame& F, const Args& a) {
    LAS float* scr = (LAS float*)(F.lds + RING_OFF + F.wave * 16384);
    int tid_ = threadIdx.x; asm volatile("" : "+v"(tid_));
    const int gw = F.vcu * NWAVES + F.wave, NGW = F.G * NWAVES, lane = tid_ & 63;
    unsigned char* ws = a.ws;
    constexpr int I_WIN = (D / 64) * (HY_LD / 32), I_WUP = (UP_K / 64) * (UP_N / 32), I_WOUT = (D / 64) * (D / 32), I_RIN = (D / 64) * (RET_IN / 32), I_ROUT = (RET_MIX / 64) * (D / 32);
    constexpr int I_GU = (D / 64) * (1024 / 32), I_D = (FF / 64) * (D / 32);
    constexpr int N_SMALL = 2 * (I_WIN + I_WUP + I_WOUT + I_RIN + I_ROUT), N_GU = DEPTH * NE * I_GU, N_D = DEPTH * NE * I_D;
    for (int it = gw; it < N_SMALL + N_GU + N_D; it += NGW) {
        int r = it;
        if (r < N_SMALL) {
            const int i = r & 1; r >>= 1;
            if (r < I_WIN) { const float* W = a.in[9] + (size_t)i * D * HY_IN; const int nblk = HY_LD / 32;
                tr_item([=](int n, int k) { return n < HY_IN ? W[(size_t)k * HY_IN + n] : 0.f; }, D, (bf16*)(ws + WS_WIN) + (size_t)i * HY_LD * D, 64 * (r / nblk), 32 * (r % nblk), scr, lane); continue; }
            r -= I_WIN;
            if (r < I_WUP) { const float* Wq = a.in[11] + (size_t)i * 256 * 768; const float* Wkv = a.in[13] + (size_t)i * 128 * 1024; const float* gq = a.in[10] + i * 256; const float* gkv = a.in[12] + i * 128; const int nblk = UP_N / 32;
                tr_item([=](int n, int k) { return n < 768 ? (k < 256 ? gq[k] * Wq[(size_t)k * 768 + n] : 0.f) : (k >= 256 ? gkv[k - 256] * Wkv[(size_t)(k - 256) * 1024 + (n - 768)] : 0.f); },
                        UP_K, (bf16*)(ws + WS_WUP) + (size_t)i * UP_N * UP_K, 64 * (r / nblk), 32 * (r % nblk), scr, lane); continue; }
            r -= I_WUP;
            if (r < I_WOUT) { const float* W = a.in[18] + (size_t)i * D * D; const int nblk = D / 32;
                tr_item([=](int n, int k) { return W[(size_t)k * D + n]; }, D, (bf16*)(ws + WS_WOUT) + (size_t)i * D * D, 64 * (r / nblk), 32 * (r % nblk), scr, lane); continue; }
            r -= I_WOUT;
            if (r < I_RIN) { const float* W = a.in[19] + (size_t)i * D * RET_IN; const int nblk = RET_IN / 32;
                tr_item([=](int n, int k) { return W[(size_t)k * RET_IN + n]; }, D, (bf16*)(ws + WS_RIN) + (size_t)i * RET_IN * D, 64 * (r / nblk), 32 * (r % nblk), scr, lane); continue; }
            r -= I_RIN;
            { const float* W = a.in[22] + (size_t)i * RET_MIX * D; const int nblk = D / 32;
                tr_item([=](int n, int k) { return W[(size_t)k * D + n]; }, RET_MIX, (bf16*)(ws + WS_ROUT) + (size_t)i * D * RET_MIX, 64 * (r / nblk), 32 * (r % nblk), scr, lane); continue; }
        }
        r -= N_SMALL;
        if (r < N_GU) { const int le = r / I_GU; r %= I_GU; const float* Wg = a.in[27] + (size_t)le * D * FF; const float* Wu = a.in[28] + (size_t)le * D * FF; const int nblk = 1024 / 32;
            tr_item([=](int n, int k) { const int G32 = n >> 5, t = n & 31; return t < 16 ? Wg[(size_t)k * FF + 16 * G32 + t] : Wu[(size_t)k * FF + 16 * G32 + t - 16]; },
                    D, (bf16*)(ws + WS_WGU) + (size_t)le * 1024 * D, 64 * (r / nblk), 32 * (r % nblk), scr, lane); continue; }
        r -= N_GU;
        { const int le = r / I_D; r %= I_D; const float* W = a.in[29] + (size_t)le * FF * D; const int nblk = D / 32;
            tr_item([=](int n, int k) { return W[(size_t)k * D + n]; }, FF, (bf16*)(ws + WS_WD) + (size_t)le * D * FF, 64 * (r / nblk), 32 * (r % nblk), scr, lane); }
    }
}

typedef short s16x4 __attribute__((ext_vector_type(4)));
typedef short v4i16_t __attribute__((ext_vector_type(4)));
__device__ __forceinline__ s16x4 lds_tr16(const LAS unsigned char* p) { return __builtin_bit_cast(s16x4, __builtin_amdgcn_ds_read_tr16_b64_v4i16((LAS v4i16_t*)p)); }
__device__ __forceinline__ f32x4 mfma16(bf16x8 a, bf16x8 b, f32x4 c) { return __builtin_amdgcn_mfma_f32_16x16x32_bf16(a, b, c, 0, 0, 0); }
__device__ __forceinline__ bf16x8 cat4(s16x4 a, s16x4 b) { return __builtin_shufflevector(a, b, 0, 1, 2, 3, 4, 5, 6, 7); }
__device__ __forceinline__ unsigned cvtpk(float lo, float hi) { typedef float f2_t __attribute__((ext_vector_type(2))); typedef __bf16 b2_t __attribute__((ext_vector_type(2))); f2_t v = {lo, hi}; b2_t b = __builtin_convertvector(v, b2_t); return __builtin_bit_cast(unsigned, b); }
__device__ __forceinline__ bf16x8 pack8(f32x4 a, f32x4 b) { v4u w; w.x = cvtpk(a[0], a[1]); w.y = cvtpk(a[2], a[3]); w.z = cvtpk(b[0], b[1]); w.w = cvtpk(b[2], b[3]); return __builtin_bit_cast(bf16x8, w); }

constexpr int AT_KSTR = 208, AT_VSTR = 144, AT_KBUF = 64 * AT_KSTR, AT_VBUF = 64 * AT_VSTR;
__device__ __forceinline__ void attn_unit(Frame& F, const bf16* __restrict__ quk, const bf16* __restrict__ Kr, bf16* __restrict__ mix, int b, int h, int qb) {
    LAS unsigned char* Kb = F.lds + RING_OFF; LAS unsigned char* Vb = F.lds + RING_OFF + 2 * AT_KBUF;
    int tid_ = threadIdx.x; asm volatile("" : "+v"(tid_));
    const int tid = tid_, lane = tid & 63, w = __builtin_amdgcn_readfirstlane(tid >> 6), g = lane >> 4, c16 = lane & 15;
    const int q0 = qb * 128 + 16 * w;
    const size_t tb = (size_t)b * SEQ;
    bf16x8 qf[3];
    { const bf16* qp = quk + (tb + q0 + c16) * UP_N + h * 96 + 8 * g;
#pragma unroll
      for (int ks = 0; ks < 3; ++ks) qf[ks] = *(const bf16x8*)(qp + 32 * ks); }
    f32x4 O[4];
#pragma unroll
    for (int mt = 0; mt < 4; ++mt) O[mt] = (f32x4){0.f, 0.f, 0.f, 0.f};
    float m = -1e30f, l = 0.f;
    const int nkt = 2 * qb + 2;
    const int krow = tid >> 3, kc = tid & 7, rrow = (tid >> 2) & 63, rc = tid & 3;
    const bf16* gK = quk + (tb + krow) * UP_N + 768 + h * 128 + kc * 8;
    const bf16* gR = Kr + (tb + rrow) * 32 + rc * 8;
    v4u rk = *(const v4u*)gK, rv = *(const v4u*)(gK + 64), rr = *(const v4u*)gR;
    const int aoffK = c16 * AT_KSTR + 16 * g;
    const int aoffV = (4 * g + (c16 >> 2)) * AT_VSTR + 8 * (lane & 3);
    for (int kt = 0; kt < nkt; ++kt) {
        LAS unsigned char* Kc = Kb + (kt & 1) * AT_KBUF; LAS unsigned char* Vc = Vb + (kt & 1) * AT_VBUF;
        *(LAS v4u*)(Kc + krow * AT_KSTR + kc * 16) = rk; *(LAS v4u*)(Vc + krow * AT_VSTR + kc * 16) = rv;
        if (tid < 256) *(LAS v4u*)(Kc + rrow * AT_KSTR + 128 + rc * 16) = rr;
        __syncthreads();
        if (kt + 1 < nkt) { const size_t off = (size_t)(kt + 1) * 64; rk = *(const v4u*)(gK + off * UP_N); rv = *(const v4u*)(gK + off * UP_N + 64); rr = *(const v4u*)(gR + off * 32); }
        const int k0 = kt * 64;
        if (k0 <= q0 + 15) {
            f32x4 S[4];
#pragma unroll
            for (int mt = 0; mt < 4; ++mt) { S[mt] = (f32x4){0.f, 0.f, 0.f, 0.f};
#pragma unroll
                for (int ks = 0; ks < 3; ++ks) { const bf16x8 a = *(const LAS bf16x8*)(Kc + aoffK + mt * 16 * AT_KSTR + ks * 64); S[mt] = mfma16(a, qf[ks], S[mt]); } }
            if (k0 + 63 > q0) {
                const int q = q0 + c16;
#pragma unroll
                for (int mt = 0; mt < 4; ++mt)
#pragma unroll
                    for (int r = 0; r < 4; ++r) if (k0 + 16 * mt + 4 * g + r > q) S[mt][r] = -1e30f;
            }
            float mx = fmaxf(fmaxf(S[0][0], S[0][1]), fmaxf(S[0][2], S[0][3]));
#pragma unroll
            for (int mt = 1; mt < 4; ++mt) mx = fmaxf(mx, fmaxf(fmaxf(S[mt][0], S[mt][1]), fmaxf(S[mt][2], S[mt][3])));
            mx = fmaxf(mx, __shfl_xor(mx, 16)); mx = fmaxf(mx, __shfl_xor(mx, 32));
            const float mn = fmaxf(m, mx), alpha = __builtin_amdgcn_exp2f(m - mn); m = mn;
            float ls = 0.f;
#pragma unroll
            for (int mt = 0; mt < 4; ++mt)
#pragma unroll
                for (int r = 0; r < 4; ++r) { S[mt][r] = __builtin_amdgcn_exp2f(S[mt][r] - mn); ls += S[mt][r]; }
            l = l * alpha + ls;
#pragma unroll
            for (int mt = 0; mt < 4; ++mt) O[mt] = O[mt] * alpha;
            bf16x8 pf[2]; pf[0] = pack8(S[0], S[1]); pf[1] = pack8(S[2], S[3]);
#pragma unroll
            for (int mt = 0; mt < 4; ++mt)
#pragma unroll
                for (int s = 0; s < 2; ++s) {
                    const s16x4 v0 = lds_tr16(Vc + aoffV + (32 * s) * AT_VSTR + mt * 32), v1 = lds_tr16(Vc + aoffV + (32 * s + 16) * AT_VSTR + mt * 32);
                    O[mt] = mfma16(cat4(v0, v1), pf[s], O[mt]);
                }
        }
    }
    l += __shfl_xor(l, 16); l += __shfl_xor(l, 32);
    const float inv = 1.f / l;
    bf16* op = mix + (tb + q0 + c16) * 1024 + h * 64 + 4 * g;
#pragma unroll
    for (int mt = 0; mt < 4; ++mt) { const f32x4 o = O[mt] * inv; typedef unsigned u2_t __attribute__((ext_vector_type(2))); u2_t wv; wv.x = cvtpk(o[0], o[1]); wv.y = cvtpk(o[2], o[3]); *(u2_t*)(op + 16 * mt) = wv; }
    __syncthreads();
}
__device__ __forceinline__ void attn_phase(Frame& F, const bf16* quk, const bf16* Kr, bf16* mix) {
    for (int u = F.vcu; u < 512; u += F.G) {
        const int bh = u >> 4, p = u & 15;
        for (int j = 0; j < 2; ++j) attn_unit(F, quk, Kr, mix, bh >> 3, bh & 7, j ? p : 31 - p);
    }
}
constexpr int RT_STR = 272, RT_TILE = 128 * RT_STR, RT_VSTR = 80, RT_VTILE = 128 * RT_VSTR;
__device__ __forceinline__ float ret_log2gamma(int h) { return log2f(1.f - exp2f(-5.f - (float)h)); }

__device__ __forceinline__ void ret_state_phase(Frame& F, const bf16* __restrict__ projb, bf16* __restrict__ ST) {
    int tid_ = threadIdx.x; asm volatile("" : "+v"(tid_));
    const int tid = tid_, lane = tid & 63, w = __builtin_amdgcn_readfirstlane(tid >> 6), g = lane >> 4, c16 = lane & 15;
    LAS unsigned char* Kt = F.lds + RING_OFF; LAS unsigned char* Vt = F.lds + RING_OFF + 2 * RT_TILE;
    for (int u = F.vcu; u < 256; u += F.G) {
        const int bh = u >> 3, slice = u & 7, b = bh >> 3, h = bh & 7;
        const float lg = ret_log2gamma(h), cdec = exp2f(128.f * lg);
        const size_t tb = (size_t)b * SEQ;
        const int vrow = tid >> 2, vc = tid & 3;
        const bf16* gKp = projb + (tb + (tid >> 4)) * RET_IN + 1024 + h * 128 + (tid & 15) * 8;
        const bf16* gVp = projb + (tb + vrow) * RET_IN + 2048 + h * 256 + slice * 32 + vc * 8;
        const float vscale = exp2f((float)(127 - vrow) * lg);
        v4u rk[4], rv;
#pragma unroll
        for (int i = 0; i < 4; ++i) rk[i] = *(const v4u*)(gKp + (size_t)(32 * i) * RET_IN);
        rv = *(const v4u*)gVp;
        f32x4 acc[2]; acc[0] = (f32x4){0.f, 0.f, 0.f, 0.f}; acc[1] = acc[0];
        bf16* stp = ST + ((size_t)bh * 32) * 256 * 128 + (size_t)(slice * 32 + 4 * g) * 128 + 16 * w + c16;
        const int toff = (8 * g + (c16 >> 2)) * RT_STR + (16 * w + 4 * (lane & 3)) * 2;
        const int voff = (8 * g + (c16 >> 2)) * RT_VSTR + (4 * (lane & 3)) * 2;
        for (int n = 0; n < 32; ++n) {
            LAS unsigned char* Kc = Kt + (n & 1) * RT_TILE; LAS unsigned char* Vc = Vt + (n & 1) * RT_VTILE;
#pragma unroll
            for (int i = 0; i < 4; ++i) *(LAS v4u*)(Kc + ((tid >> 4) + 32 * i) * RT_STR + (tid & 15) * 16) = rk[i];
            { v4u o;
#pragma unroll
              for (int j = 0; j < 4; ++j) { const unsigned x = rv[j]; o[j] = cvtpk(__uint_as_float(x << 16) * vscale, __uint_as_float(x & 0xffff0000u) * vscale); }
              *(LAS v4u*)(Vc + vrow * RT_VSTR + vc * 16) = o; }
            __syncthreads();
            if (n + 1 < 32) {
#pragma unroll
                for (int i = 0; i < 4; ++i) rk[i] = *(const v4u*)(gKp + (size_t)((n + 1) * 128 + 32 * i) * RET_IN);
                rv = *(const v4u*)(gVp + (size_t)((n + 1) * 128) * RET_IN);
            }
            { bf16* sp = stp + (size_t)n * 256 * 128;
#pragma unroll
              for (int mt = 0; mt < 2; ++mt)
#pragma unroll
                  for (int r = 0; r < 4; ++r) sp[(16 * mt + r) * 128] = (bf16)(cvtpk(acc[mt][r], 0.f) & 0xffffu); }
            acc[0] = acc[0] * cdec; acc[1] = acc[1] * cdec;
#pragma unroll
            for (int ks = 0; ks < 4; ++ks) {
                const bf16x8 bk = cat4(lds_tr16(Kc + toff + (32 * ks) * RT_STR), lds_tr16(Kc + toff + (32 * ks + 4) * RT_STR));
#pragma unroll
                for (int mt = 0; mt < 2; ++mt) {
                    const bf16x8 av = cat4(lds_tr16(Vc + voff + (32 * ks) * RT_VSTR + mt * 32), lds_tr16(Vc + voff + (32 * ks + 4) * RT_VSTR + mt * 32));
                    acc[mt] = mfma16(av, bk, acc[mt]);
                }
            }
        }
        __syncthreads();
    }
}

__device__ __forceinline__ void ret_chunk_phase(Frame& F, const bf16* __restrict__ projb, const bf16* __restrict__ ST, const float* __restrict__ gn_g, const float* __restrict__ gn_b, bf16* __restrict__ mix) {
    int tid_ = threadIdx.x; asm volatile("" : "+v"(tid_));
    const int tid = tid_, lane = tid & 63, w = __builtin_amdgcn_readfirstlane(tid >> 6), g = lane >> 4, c16 = lane & 15;
    LAS unsigned char* Kt = F.lds + RING_OFF; LAS unsigned char* Vt = Kt + RT_TILE; LAS unsigned char* St = Vt + RT_TILE;
    const int srow = tid >> 4, sc = tid & 15;
    for (int u = F.vcu; u < 1024; u += F.G) {
        const int bh = u >> 5, n = u & 31, b = bh >> 3, h = bh & 7;
        const float lg = ret_log2gamma(h);
        const size_t t0 = (size_t)b * SEQ + (size_t)n * 128;
        const bf16* gK = projb + (t0 + srow) * RET_IN + 1024 + h * 128 + sc * 8;
        const bf16* gV = projb + (t0 + srow) * RET_IN + 2048 + h * 256 + sc * 8;
        const bf16* gS = ST + ((size_t)bh * 32 + n) * 256 * 128 + (size_t)srow * 128 + sc * 8;
        v4u rk[4], rv[4], rs[4];
#pragma unroll
        for (int i = 0; i < 4; ++i) { rk[i] = *(const v4u*)(gK + (size_t)(32 * i) * RET_IN); rv[i] = *(const v4u*)(gV + (size_t)(32 * i) * RET_IN); rs[i] = *(const v4u*)(gS + (size_t)(32 * i) * 128); }
        bf16x8 qf[4];
        { const bf16* qp = projb + (t0 + 16 * w + c16) * RET_IN + h * 128 + 8 * g;
#pragma unroll
          for (int ks = 0; ks < 4; ++ks) qf[ks] = *(const bf16x8*)(qp + 32 * ks); }
#pragma unroll
        for (int i = 0; i < 4; ++i) { const int o = (srow + 32 * i) * RT_STR + sc * 16; *(LAS v4u*)(Kt + o) = rk[i]; *(LAS v4u*)(Vt + o) = rv[i]; *(LAS v4u*)(St + o) = rs[i]; }
        __syncthreads();
#pragma unroll
        for (int i = 0; i < 4; ++i) { rv[i] = *(const v4u*)(gV + (size_t)(32 * i) * RET_IN + 128); rs[i] = *(const v4u*)(gS + (size_t)(32 * i) * 128 + 128 * 128); }
        const int irow = 16 * w + c16;
        bf16x8 pf[4];
        {
            const int koff = c16 * RT_STR + 16 * g;
            f32x4 P[8];
#pragma unroll
            for (int mt = 0; mt < 8; ++mt) {
                P[mt] = (f32x4){0.f, 0.f, 0.f, 0.f};
                if (mt <= w) {
#pragma unroll
                    for (int ks = 0; ks < 4; ++ks) P[mt] = mfma16(*(const LAS bf16x8*)(Kt + koff + mt * 16 * RT_STR + ks * 64), qf[ks], P[mt]);
#pragma unroll
                    for (int r = 0; r < 4; ++r) { const int j = 16 * mt + 4 * g + r; P[mt][r] = (j <= irow) ? P[mt][r] * __builtin_amdgcn_exp2f((float)(irow - j) * lg) : 0.f; }
                }
            }
#pragma unroll
            for (int s = 0; s < 4; ++s) pf[s] = pack8(P[2 * s], P[2 * s + 1]);
        }
        const float cdi = __builtin_amdgcn_exp2f((float)(irow + 1) * lg);
        f32x4 acc[2][8];
        const int soff = c16 * RT_STR + 16 * g;
        const int voff = (4 * g + (c16 >> 2)) * RT_STR + 8 * (lane & 3);
#pragma unroll
        for (int hf = 0; hf < 2; ++hf) {
            if (hf == 1) {
                __syncthreads();
#pragma unroll
                for (int i = 0; i < 4; ++i) { const int o = (srow + 32 * i) * RT_STR + sc * 16; *(LAS v4u*)(Vt + o) = rv[i]; *(LAS v4u*)(St + o) = rs[i]; }
                __syncthreads();
            }
#pragma unroll
            for (int mt = 0; mt < 8; ++mt) {
                f32x4 a = (f32x4){0.f, 0.f, 0.f, 0.f};
#pragma unroll
                for (int ks = 0; ks < 4; ++ks) a = mfma16(*(const LAS bf16x8*)(St + soff + mt * 16 * RT_STR + ks * 64), qf[ks], a);
                acc[hf][mt] = a * cdi;
            }
#pragma unroll
            for (int s = 0; s < 4; ++s) {
                if (2 * s <= w) {
#pragma unroll
                    for (int mt = 0; mt < 8; ++mt)
                        acc[hf][mt] = mfma16(cat4(lds_tr16(Vt + voff + (32 * s) * RT_STR + mt * 32), lds_tr16(Vt + voff + (32 * s + 16) * RT_STR + mt * 32)), pf[s], acc[hf][mt]);
                }
            }
        }
        float s1 = 0.f;
#pragma unroll
        for (int hf = 0; hf < 2; ++hf)
#pragma unroll
            for (int mt = 0; mt < 8; ++mt) s1 += (acc[hf][mt][0] + acc[hf][mt][1]) + (acc[hf][mt][2] + acc[hf][mt][3]);
        s1 += __shfl_xor(s1, 16); s1 += __shfl_xor(s1, 32);
        const float mean = s1 * (1.f / 256.f);
        float s2 = 0.f;
#pragma unroll
        for (int hf = 0; hf < 2; ++hf)
#pragma unroll
            for (int mt = 0; mt < 8; ++mt) { const f32x4 d = acc[hf][mt] - mean; s2 += (d[0] * d[0] + d[1] * d[1]) + (d[2] * d[2] + d[3] * d[3]); }
        s2 += __shfl_xor(s2, 16); s2 += __shfl_xor(s2, 32);
        const float rstd = rsqrtf(s2 * (1.f / 256.f) + LN_EPS);
        const size_t trow = t0 + irow;
#pragma unroll
        for (int hf = 0; hf < 2; ++hf)
#pragma unroll
            for (int mt = 0; mt < 8; ++mt) {
                const int c = h * 256 + hf * 128 + 16 * mt + 4 * g;
                typedef unsigned u2_t __attribute__((ext_vector_type(2)));
                const u2_t gw = *(const u2_t*)(projb + trow * RET_IN + 4096 + c);
                const f32x4 gg = *(const f32x4*)(gn_g + c), gb = *(const f32x4*)(gn_b + c);
                const float g0 = __uint_as_float(gw.x << 16), g1 = __uint_as_float(gw.x & 0xffff0000u), g2 = __uint_as_float(gw.y << 16), g3 = __uint_as_float(gw.y & 0xffff0000u);
                const f32x4 o = (acc[hf][mt] - mean) * rstd * gg + gb;
                u2_t ov; ov.x = cvtpk(silu_f(g0) * o[0], silu_f(g1) * o[1]); ov.y = cvtpk(silu_f(g2) * o[2], silu_f(g3) * o[3]);
                *(u2_t*)(mix + trow * RET_MIX + c) = ov;
            }
        __syncthreads();
    }
}
constexpr int GD_STR = 144, GD_TILE = 64 * GD_STR, GD_WAVE_LDS = 3 * GD_TILE + 512;
constexpr int GD_UNIT_ELEMS = 5 * 4096;
__device__ __forceinline__ float bflo(unsigned x) { return __uint_as_float(x << 16); }
__device__ __forceinline__ float bfhi(unsigned x) { return __uint_as_float(x & 0xffff0000u); }

__device__ __forceinline__ void gdn_conv64(const bf16* __restrict__ prow, int cb, const float* __restrict__ cw, int nvalid  , float (&out)[64]) {
    float mk[4]; ptrdiff_t ro[4];
#pragma unroll
    for (int k = 0; k < 4; ++k) { const bool ok = (k >= 4 - nvalid); mk[k] = ok ? 1.f : 0.f; ro[k] = ok ? (ptrdiff_t)(k - 3) * HY_LD : 0; }
#pragma unroll
    for (int cc = 0; cc < 8; ++cc) {
        float acc[8];
#pragma unroll
        for (int e = 0; e < 8; ++e) acc[e] = 0.f;
#pragma unroll
        for (int k = 0; k < 4; ++k) {
            const v4u x = *(const v4u*)(prow + ro[k] + cb + cc * 8);
            const float* wk = cw + k * 1536 + cb + cc * 8;
#pragma unroll
            for (int e2 = 0; e2 < 4; ++e2) { acc[2 * e2] += (wk[2 * e2] * mk[k]) * bflo(x[e2]); acc[2 * e2 + 1] += (wk[2 * e2 + 1] * mk[k]) * bfhi(x[e2]); }
        }
#pragma unroll
        for (int e = 0; e < 8; ++e) out[cc * 8 + e] = silu_f(acc[e]);
        asm volatile("" ::: "memory"); __builtin_amdgcn_sched_barrier(0);
    }
}
__device__ __forceinline__ void lds_put_row(LAS unsigned char* rowp, const float (&v)[64], float sc) {
#pragma unroll
    for (int cc = 0; cc < 8; ++cc) { v4u o;
#pragma unroll
        for (int e2 = 0; e2 < 4; ++e2) o[e2] = cvtpk(v[cc * 8 + 2 * e2] * sc, v[cc * 8 + 2 * e2 + 1] * sc);
        *(LAS v4u*)(rowp + cc * 16) = o; }
}
template <int I> __device__ __forceinline__ void fs_row(float (&Tc)[64], const LAS unsigned char* T0, int lane) {
    constexpr int NC = (I + 7) / 8;
    float acc = (I == lane) ? 1.f : 0.f;
    if constexpr (NC > 0) {
        v4u rw[NC];
#pragma unroll
        for (int jc = 0; jc < NC; ++jc) rw[jc] = *(const LAS v4u*)(T0 + I * GD_STR + jc * 16);
#pragma unroll
        for (int jc = 0; jc < NC; ++jc)
#pragma unroll
            for (int e2 = 0; e2 < 4; ++e2) {
                if (jc * 8 + 2 * e2 < I) acc -= bflo(rw[jc][e2]) * Tc[jc * 8 + 2 * e2];
                if (jc * 8 + 2 * e2 + 1 < I) acc -= bfhi(rw[jc][e2]) * Tc[jc * 8 + 2 * e2 + 1];
            }
    }
    Tc[I] = acc;
    __builtin_amdgcn_sched_barrier(0);
}
template <int I0, int I1> struct FsRange {
    static __device__ __forceinline__ void run(float (&Tc)[64], const LAS unsigned char* T0, int lane) {
        if constexpr (I1 - I0 == 1) fs_row<I0>(Tc, T0, lane);
        else { FsRange<I0, (I0 + I1) / 2>::run(Tc, T0, lane); FsRange<(I0 + I1) / 2, I1>::run(Tc, T0, lane); }
    }
};
__device__ __forceinline__ void gdn_prep_unit(const bf16* __restrict__ projb, const float* __restrict__ conv_w, const float* __restrict__ a_log, const float* __restrict__ dt_bias,
                                              bf16* __restrict__ GD, float* __restrict__ GL, int unit, int lane_in, LAS unsigned char* lw) {
    int lane = lane_in; asm volatile("" : "+v"(lane));
    const int bh = unit >> 6, n = unit & 63, b = bh >> 3, h = bh & 7, g = lane >> 4, c16 = lane & 15;
    const size_t t0 = (size_t)b * SEQ + (size_t)n * 64;
    LAS unsigned char* T0 = lw; LAS unsigned char* Kt = lw + GD_TILE; LAS unsigned char* Vt = lw + 2 * GD_TILE;
    LAS float* gbuf = (LAS float*)(lw + 3 * GD_TILE); LAS float* bbuf = gbuf + 64;
    bf16* gd = GD + (size_t)unit * GD_UNIT_ELEMS;
    const bf16* prow = projb + (t0 + lane) * HY_LD + MLA_COLS;
    const int spos = n * 64 + lane; const int nvalid = spos >= 3 ? 4 : spos + 1;
    const float av = bf2f(prow[1536 + h]), bv = bf2f(prow[1544 + h]);
    const float beta = 1.f / (1.f + expf(-bv));
    const float z = av + dt_bias[h];
    const float la = -expf(a_log[h]) * ((z > 20.f) ? z : log1pf(expf(z)));
    float gs = la;
#pragma unroll
    for (int o = 1; o < 64; o <<= 1) { const float t = __shfl_up(gs, o); if (lane >= o) gs += t; }
    const float glast = __shfl(gs, 63);
    const float eg = expf(gs);
    gbuf[lane] = gs; bbuf[lane] = beta;
    if (lane == 0) GL[unit] = expf(glast);
    {
        float r[64];
        gdn_conv64(prow, h * 64, conv_w, nvalid, r);
        float ss = 0.f;
#pragma unroll
        for (int e = 0; e < 64; ++e) ss += r[e] * r[e];
        const float rn = rsqrtf(ss + RMS_EPS) * 0.125f;
        lds_put_row(T0 + lane * GD_STR, r, rn);
        { const float sc = rn * eg; bf16* qg = gd + 3 * 4096 + lane * 64;
#pragma unroll
          for (int cc = 0; cc < 8; ++cc) { v4u o;
#pragma unroll
              for (int e2 = 0; e2 < 4; ++e2) o[e2] = cvtpk(r[cc * 8 + 2 * e2] * sc, r[cc * 8 + 2 * e2 + 1] * sc);
              *(v4u*)(qg + cc * 8) = o; } }
        gdn_conv64(prow, 512 + h * 64, conv_w, nvalid, r);
        ss = 0.f;
#pragma unroll
        for (int e = 0; e < 64; ++e) ss += r[e] * r[e];
        const float rk = rsqrtf(ss + RMS_EPS);
        lds_put_row(Kt + lane * GD_STR, r, rk);
        { const float sc = rk * expf(glast - gs); bf16* kd = gd + 4 * 4096 + lane;
#pragma unroll
          for (int e = 0; e < 64; ++e) kd[e * 64] = (bf16)(cvtpk(r[e] * sc, 0.f) & 0xffffu); }
        gdn_conv64(prow, 1024 + h * 64, conv_w, nvalid, r);
        lds_put_row(Vt + lane * GD_STR, r, 1.f);
    }
    asm volatile("s_waitcnt lgkmcnt(0)" ::: "memory"); __builtin_amdgcn_sched_barrier(0);
    {
        bf16* ai = gd;
#pragma unroll
        for (int m = 0; m < 4; ++m) {
            f32x4 qk[4], kk[4];
#pragma unroll
            for (int nn = 0; nn <= m; ++nn) {
                qk[nn] = (f32x4){0.f, 0.f, 0.f, 0.f}; kk[nn] = qk[nn];
#pragma unroll
                for (int ks = 0; ks < 2; ++ks) {
                    const bf16x8 aq = *(const LAS bf16x8*)(T0 + (16 * m + c16) * GD_STR + (32 * ks + 8 * g) * 2);
                    const bf16x8 ak = *(const LAS bf16x8*)(Kt + (16 * m + c16) * GD_STR + (32 * ks + 8 * g) * 2);
                    const bf16x8 bk = *(const LAS bf16x8*)(Kt + (16 * nn + c16) * GD_STR + (32 * ks + 8 * g) * 2);
                    qk[nn] = mfma16(aq, bk, qk[nn]); kk[nn] = mfma16(ak, bk, kk[nn]);
                }
            }
            asm volatile("s_waitcnt lgkmcnt(0)" ::: "memory"); __builtin_amdgcn_sched_barrier(0);
#pragma unroll
            for (int nn = 0; nn < 4; ++nn) {
                if (nn <= m) {
                    const int j = 16 * nn + c16; const float gj = gbuf[j];
#pragma unroll
                    for (int r = 0; r < 4; ++r) {
                        const int i = 16 * m + 4 * g + r; const float gi = gbuf[i], bi = bbuf[i];
                        const float dec = (i >= j) ? expf(gi - gj) : 0.f;
                        ai[i * 64 + j] = (bf16)(cvtpk(qk[nn][r] * dec, 0.f) & 0xffffu);
                        const float lv = (i > j) ? kk[nn][r] * bi * dec : 0.f;
                        *(LAS bf16*)(T0 + i * GD_STR + j * 2) = (bf16)(cvtpk(lv, 0.f) & 0xffffu);
                    }
                } else {
#pragma unroll
                    for (int r = 0; r < 4; ++r) ai[(16 * m + 4 * g + r) * 64 + 16 * nn + c16] = (bf16)0;
                }
            }
            asm volatile("s_waitcnt lgkmcnt(0)" ::: "memory"); __builtin_amdgcn_sched_barrier(0);
        }
    }
    asm volatile("s_waitcnt lgkmcnt(0)" ::: "memory"); __builtin_amdgcn_sched_barrier(0);
    float Tc[64];
    FsRange<0, 64>::run(Tc, T0, lane);
    asm volatile("s_waitcnt lgkmcnt(0)" ::: "memory"); __builtin_amdgcn_sched_barrier(0);
#pragma unroll
    for (int pass = 0; pass < 2; ++pass) {
        const float sc = pass ? beta * eg : beta;
#pragma unroll
        for (int i = 0; i < 64; ++i) *(LAS bf16*)(T0 + i * GD_STR + lane * 2) = (bf16)(cvtpk(Tc[i] * sc, 0.f) & 0xffffu);
        asm volatile("s_waitcnt lgkmcnt(0)" ::: "memory");
        const LAS unsigned char* Bt = pass ? Kt : Vt;
        bf16* outp = gd + (pass ? 2 : 1) * 4096;
#pragma unroll
        for (int m = 0; m < 4; ++m)
#pragma unroll
            for (int nn = 0; nn < 4; ++nn) {
                f32x4 acc = (f32x4){0.f, 0.f, 0.f, 0.f};
#pragma unroll
                for (int ks = 0; ks < 2; ++ks) {
                    const bf16x8 a = *(const LAS bf16x8*)(T0 + (16 * m + c16) * GD_STR + (32 * ks + 8 * g) * 2);
                    const int ro = (32 * ks + 8 * g + (c16 >> 2)) * GD_STR + (16 * nn + 4 * (lane & 3)) * 2;
                    acc = mfma16(a, cat4(lds_tr16(Bt + ro), lds_tr16(Bt + ro + 4 * GD_STR)), acc);
                }
#pragma unroll
                for (int r = 0; r < 4; ++r) outp[(16 * m + 4 * g + r) * 64 + 16 * nn + c16] = (bf16)(cvtpk(acc[r], 0.f) & 0xffffu);
                __builtin_amdgcn_sched_barrier(0);
            }
        asm volatile("s_waitcnt lgkmcnt(0)" ::: "memory");
    }
}
__device__ __forceinline__ void gdn_prep_phase(Frame& F, const bf16* projb, const float* conv_w, const float* a_log, const float* dt_bias, bf16* GD, float* GL) {
    int tid_ = threadIdx.x; asm volatile("" : "+v"(tid_));
    const int tid = tid_, lane = tid & 63, w = __builtin_amdgcn_readfirstlane(tid >> 6);
    if (w < 4) {
        LAS unsigned char* lw = F.lds + RING_OFF + w * GD_WAVE_LDS;
        for (int u = F.vcu * 4 + w; u < 2048; u += F.G * 4) gdn_prep_unit(projb, conv_w, a_log, dt_bias, GD, GL, u, lane, lw);
    }
    __syncthreads();
}

constexpr int GS_BUF = 5 * GD_TILE, GS_OSTR = 272, GS_OBUF = 64 * GS_OSTR;
__device__ __forceinline__ bf16x8 ld_perm(const LAS unsigned char* p) {
    return cat4(*(const LAS s16x4*)p, *(const LAS s16x4*)(p + 32));
}
__device__ __forceinline__ void gdn_scan_unit(Frame& F, const bf16* __restrict__ GD, const float* __restrict__ GL, const bf16* __restrict__ projb, const float* __restrict__ o_norm, bf16* __restrict__ mix, int bh) {
    int tid_ = threadIdx.x; asm volatile("" : "+v"(tid_));
    const int tid = tid_, lane = tid & 63, w = __builtin_amdgcn_readfirstlane(tid >> 6), g = lane >> 4, c16 = lane & 15;
    LAS unsigned char* Bf = F.lds + RING_OFF; LAS unsigned char* Ob = F.lds + RING_OFF + 2 * GS_BUF;
    const int b = bh >> 3, h = bh & 7;
    const bf16* gsrc = GD + (size_t)bh * 64 * GD_UNIT_ELEMS + (size_t)(tid >> 3) * 64 + (tid & 7) * 8;
    const int ldst = (tid >> 3) * GD_STR + (tid & 7) * 16;
    v4u rg[5];
#pragma unroll
    for (int i = 0; i < 5; ++i) rg[i] = *(const v4u*)(gsrc + i * 4096);
    f32x4 S[4];
#pragma unroll
    for (int m = 0; m < 4; ++m) S[m] = (f32x4){0.f, 0.f, 0.f, 0.f};
    const int aoff = c16 * GD_STR + 8 * g;
    for (int n = 0; n <= 64; ++n) {
        if (n < 64) {
            LAS unsigned char* Bc = Bf + (n & 1) * GS_BUF;
#pragma unroll
            for (int i = 0; i < 5; ++i) *(LAS v4u*)(Bc + i * GD_TILE + ldst) = rg[i];
        }
        __syncthreads();
        if (n + 1 < 64) {
#pragma unroll
            for (int i = 0; i < 5; ++i) rg[i] = *(const v4u*)(gsrc + (size_t)(n + 1) * GD_UNIT_ELEMS + i * 4096);
        }
        if (w < 4) {
            if (n < 64) {
                const LAS unsigned char* Bc = Bf + (n & 1) * GS_BUF;
                const LAS unsigned char* Ai = Bc; const LAS unsigned char* Ut = Bc + GD_TILE; const LAS unsigned char* Wt = Bc + 2 * GD_TILE;
                const LAS unsigned char* Qg = Bc + 3 * GD_TILE; const LAS unsigned char* Kd = Bc + 4 * GD_TILE;
                const float egl = GL[bh * 64 + n];
                bf16x8 sb[2]; sb[0] = pack8(S[0], S[1]); sb[1] = pack8(S[2], S[3]);
                f32x4 vn[4], o[4];
#pragma unroll
                for (int m = 0; m < 4; ++m) {
                    f32x4 a = (f32x4){0.f, 0.f, 0.f, 0.f}; f32x4 oq = a;
#pragma unroll
                    for (int s = 0; s < 2; ++s) { a = mfma16(ld_perm(Wt + aoff + m * 16 * GD_STR + s * 64), sb[s], a); oq = mfma16(ld_perm(Qg + aoff + m * 16 * GD_STR + s * 64), sb[s], oq); }
#pragma unroll
                    for (int r = 0; r < 4; ++r) vn[m][r] = bf2f(*(const LAS bf16*)(Ut + (16 * m + 4 * g + r) * GD_STR + (16 * w + c16) * 2)) - a[r];
                    o[m] = oq;
                }
                bf16x8 vb[2]; vb[0] = pack8(vn[0], vn[1]); vb[1] = pack8(vn[2], vn[3]);
#pragma unroll
                for (int m = 0; m < 4; ++m) {
                    S[m] = S[m] * egl;
#pragma unroll
                    for (int s = 0; s < 2; ++s) { o[m] = mfma16(ld_perm(Ai + aoff + m * 16 * GD_STR + s * 64), vb[s], o[m]); S[m] = mfma16(ld_perm(Kd + aoff + m * 16 * GD_STR + s * 64), vb[s], S[m]); }
                }
                LAS unsigned char* Oc = Ob + (n & 1) * GS_OBUF;
#pragma unroll
                for (int m = 0; m < 4; ++m)
#pragma unroll
                    for (int r = 0; r < 4; ++r) *(LAS float*)(Oc + (16 * m + 4 * g + r) * GS_OSTR + (16 * w + c16) * 4) = o[m][r];
            }
        } else if (n > 0) {
            const LAS unsigned char* Oc = Ob + ((n - 1) & 1) * GS_OBUF;
            const int row = (tid - 256) >> 2, q4 = tid & 3;
            f32x4 v[4]; float ss = 0.f;
#pragma unroll
            for (int i = 0; i < 4; ++i) { v[i] = *(const LAS f32x4*)(Oc + row * GS_OSTR + (16 * q4 + 4 * i) * 4); ss += (v[i][0] * v[i][0] + v[i][1] * v[i][1]) + (v[i][2] * v[i][2] + v[i][3] * v[i][3]); }
            ss += __shfl_xor(ss, 1); ss += __shfl_xor(ss, 2);
            const float rn = rsqrtf(ss * (1.f / 64.f) + RMS_EPS);
            const size_t t = (size_t)b * SEQ + (size_t)(n - 1) * 64 + row;
            const bf16* gp = projb + t * HY_LD + MLA_COLS + 1552 + h * 64 + 16 * q4;
            const v4u g0 = *(const v4u*)gp, g1 = *(const v4u*)(gp + 8);
            const float* on = o_norm + 16 * q4;
            v4u o0, o1;
#pragma unroll
            for (int e2 = 0; e2 < 4; ++e2) {
                const int i0 = 2 * e2, i1 = 2 * e2 + 1;
                o0[e2] = cvtpk(v[i0 >> 2][i0 & 3] * rn * on[i0] * silu_f(bflo(g0[e2])), v[i1 >> 2][i1 & 3] * rn * on[i1] * silu_f(bfhi(g0[e2])));
                o1[e2] = cvtpk(v[2 + (i0 >> 2)][i0 & 3] * rn * on[8 + i0] * silu_f(bflo(g1[e2])), v[2 + (i1 >> 2)][i1 & 3] * rn * on[8 + i1] * silu_f(bfhi(g1[e2])));
            }
            bf16* mp = mix + t * 1024 + 512 + h * 64 + 16 * q4;
            *(v4u*)mp = o0; *(v4u*)(mp + 8) = o1;
        }
    }
    __syncthreads();
}
__device__ __forceinline__ void attn_gdn_phase(Frame& F, const bf16* quk, const bf16* Kr, bf16* mix, const bf16* GD, const float* GL, const bf16* projb, const float* o_norm, gu32* qctr) {
    if (F.vcu < 32) gdn_scan_unit(F, GD, GL, projb, o_norm, mix, F.vcu);
    for (;;) {
        if (threadIdx.x == 0) F.MISC[16] = __hip_atomic_fetch_add(qctr, 1u, RLX_AGENT);
        __syncthreads();
        const unsigned k = F.MISC[16];
        __syncthreads();
        if (k >= 1024u) break;
        const int qb = 31 - (int)(k >> 5), bh = (int)(k & 31u);
        attn_unit(F, quk, Kr, mix, bh >> 3, bh & 7, qb);
    }
}
__global__ void __launch_bounds__(NWAVES * 64, 2) mega(Args args) {
    extern __shared__ __attribute__((aligned(16))) unsigned char lds[];
    Frame F;
    F.lds = (LAS unsigned char*)lds; F.MISC = (volatile LAS unsigned*)(F.lds + MISC_OFF);
    F.tid = threadIdx.x; F.lane = F.tid & 63; F.wave = __builtin_amdgcn_readfirstlane(F.tid >> 6);
    F.G = gridDim.x; { const int bx = blockIdx.x; F.vcu = (F.G % 8 == 0) ? (bx % 8) * (F.G / 8) + bx / 8 : bx; }
    unsigned char* ws = args.ws;
    F.ctl = (gu32*)(ws + WS_CTL);
    for (int u = F.tid; u < (LDS_BYTES - LDSCTL_OFF) / 4; u += NWAVES * 64) ((LAS unsigned*)(F.lds + LDSCTL_OFF))[u] = 0u;
    __syncthreads();
    const int lo = args.ph_lo, hi = args.ph_hi;
#define IN(k) (lo <= (k) && (k) < hi)
    XcdBarrier bar = xcd_barrier_post((unsigned*)(F.ctl + CW_BAR) + args.li * XCD_BAR_WORDS, F.MISC + 8);
#define SEAM(k) do { if (IN(k) && IN((k) + 1)) xcd_barrier(bar); } while (0)
#define WSP(name) unsigned char* name = args.ws; asm volatile("" : "+s"(name))
#define GEMM_PHASE(EPI, SCHED, g, S, E) pg8::gemm_phase<EPI, SCHED, PG8_ALIGN, PG8_SP2>(F.lds + RING_OFF, g, S, E)
    if (IN(0)) p0_weights(F, args);
    for (int l = 0; l < DEPTH; ++l) {
        const int pb = 1 + l * 16;
        if ((l & 1) == 0) {
            if (IN(pb + 0)) { WSP(ws); const int i = l >> 1; pg8::Gemm g{(const bf16*)(ws + WS_HB), (const bf16*)(ws + WS_WIN) + (size_t)i * HY_LD * D, T, HY_LD, D}; pg8::StaticOrder S; S.init(T, HY_LD, F.G, (int)blockIdx.x);
                pg8::EpiB16 E{(bf16*)(ws + WS_R1), HY_LD, -1}; GEMM_PHASE(pg8::EpiB16, pg8::StaticOrder, g, S, E); }
            if (IN(pb + 2)) { WSP(ws); const int i = l >> 1; pg8::Gemm g{(const bf16*)(ws + WS_UPA), (const bf16*)(ws + WS_WUP) + (size_t)i * UP_N * UP_K, T, UP_N, UP_K}; pg8::StaticOrder S; S.init(T, UP_N, F.G, (int)blockIdx.x);
                pg8::EpiB16 E{(bf16*)(ws + WS_QUK), UP_N, -1}; GEMM_PHASE(pg8::EpiB16, pg8::StaticOrder, g, S, E); }
            if (IN(pb + 1)) { WSP(ws); const int i = l >> 1; gdn_prep_phase(F, (const bf16*)(ws + WS_R1), args.in[14] + (size_t)i * 4 * 1536, args.in[15] + i * 8, args.in[16] + i * 8, (bf16*)(ws + WS_GD), (float*)(ws + WS_GL)); }
            if (IN(pb + 3)) { WSP(ws); const int i = l >> 1; attn_gdn_phase(F, (const bf16*)(ws + WS_QUK), (const bf16*)(ws + WS_KR), (bf16*)(ws + WS_R2), (const bf16*)(ws + WS_GD), (const float*)(ws + WS_GL),
                                                                   (const bf16*)(ws + WS_R1), args.in[17] + i * 64, (gu32*)(ws + WS_CTL) + CW_AQ + 64 * l); }
            if (IN(pb + 4)) { WSP(ws); const int i = l >> 1; pg8::Gemm g{(const bf16*)(ws + WS_R2), (const bf16*)(ws + WS_WOUT) + (size_t)i * D * D, T, D, D}; pg8::StaticOrder S; S.init(T, D, F.G, (int)blockIdx.x);
                pg8::EpiF32 E{(float*)(ws + WS_Y), D, -1}; GEMM_PHASE(pg8::EpiF32, pg8::StaticOrder, g, S, E); }
        } else {
            if (IN(pb + 0)) { WSP(ws); const int i = l >> 1; pg8::Gemm g{(const bf16*)(ws + WS_HB), (const bf16*)(ws + WS_RIN) + (size_t)i * RET_IN * D, T, RET_IN, D}; pg8::StaticOrder S; S.init(T, RET_IN, F.G, (int)blockIdx.x);
                pg8::EpiB16 E{(bf16*)(ws + WS_R1), RET_IN, -1}; GEMM_PHASE(pg8::EpiB16, pg8::StaticOrder, g, S, E); }
            if (IN(pb + 1)) { WSP(ws); ret_state_phase(F, (const bf16*)(ws + WS_R1), (bf16*)(ws + WS_ST)); }
            if (IN(pb + 3)) { WSP(ws); const int i = l >> 1; ret_chunk_phase(F, (const bf16*)(ws + WS_R1), (const bf16*)(ws + WS_ST), args.in[20] + (size_t)i * RET_MIX, args.in[21] + (size_t)i * RET_MIX, (bf16*)(ws + WS_R2)); }
            if (IN(pb + 4)) { WSP(ws); const int i = l >> 1; pg8::Gemm g{(const bf16*)(ws + WS_R2), (const bf16*)(ws + WS_ROUT) + (size_t)i * D * RET_MIX, T, D, RET_MIX}; pg8::StaticOrder S; S.init(T, D, F.G, (int)blockIdx.x);
                pg8::EpiF32 E{(float*)(ws + WS_Y), D, -1}; GEMM_PHASE(pg8::EpiF32, pg8::StaticOrder, g, S, E); }
        }
        if (IN(pb + 7)) { WSP(ws); const int nt = (int)__hip_atomic_load((gu32*)(ws + WS_CTL) + CW_NTILES, RLX_AGENT);
            pg8::Gemm g{(const bf16*)(ws + WS_R1), (const bf16*)(ws + WS_WGU) + (size_t)l * NE * 1024 * D, XP_ROWS, NE * 1024, D}; pg8::GroupedOrder S{(const int*)(ws + WS_CTL) + CW_TEXP, nt * 4, F.G, (int)blockIdx.x};
            pg8::EpiSiluMul E{(bf16*)(ws + WS_HID), FF}; GEMM_PHASE(pg8::EpiSiluMul, pg8::GroupedOrder, g, S, E); }
        SEAM(pb + 7);
        if (IN(pb + 8)) { WSP(ws); const int nt = (int)__hip_atomic_load((gu32*)(ws + WS_CTL) + CW_NTILES, RLX_AGENT);
            pg8::Gemm g{(const bf16*)(ws + WS_HID), (const bf16*)(ws + WS_WD) + (size_t)l * NE * D * FF, XP_ROWS, NE * 1024, FF}; pg8::GroupedOrder S{(const int*)(ws + WS_CTL) + CW_TEXP, nt * 4, F.G, (int)blockIdx.x};
            pg8::EpiF32 E{(float*)(ws + WS_R2), D, 3}; GEMM_PHASE(pg8::EpiF32, pg8::GroupedOrder, g, S, E); }
    }
#undef IN
}
}

extern "C" void kernel_launch(void* const* d_in, const int* in_sizes, int n_in, void* d_out, int out_size, void* d_ws, size_t ws_size, hipStream_t stream) {
    static int grid = 0;
    if (grid == 0) {
        if (ws_size < WS_END || n_in != 30) { fprintf(stderr, "kernel_launch: ws %zu < %zu or n_in %d\n", ws_size, (size_t)WS_END, n_in); grid = -1; return; }
        int dev = 0, cus = 0;
        hipGetDevice(&dev); hipDeviceGetAttribute(&cus, hipDeviceAttributeMultiprocessorCount, dev);
        if (hipFuncSetAttribute((const void*)mega, hipFuncAttributeMaxDynamicSharedMemorySize, LDS_BYTES) != hipSuccess) { fprintf(stderr, "kernel_launch: hipFuncSetAttribute failed\n"); grid = -1; return; }
        grid = cus;
    }
    if (grid < 0) return;
    const float* x_in = (const float*)d_in[0]; const float* c = (const float*)d_in[1]; const int* positions = (const int*)d_in[2];
    const float* ada_w = (const float*)d_in[3]; const float* ada_b = (const float*)d_in[4];
    const float* ln_mix_g = (const float*)d_in[5]; const float* ln_mix_b = (const float*)d_in[6];
    const float* ln_ffn_g = (const float*)d_in[7]; const float* ln_ffn_b = (const float*)d_in[8];
    const float* gdn_conv_w = (const float*)d_in[14];
    const float* gdn_a_log = (const float*)d_in[15]; const float* gdn_dt_bias = (const float*)d_in[16]; const float* gdn_norm = (const float*)d_in[17];
    const float* ret_gn_g = (const float*)d_in[20]; const float* ret_gn_b = (const float*)d_in[21];
    const float* moe_w_group = (const float*)d_in[23]; const float* moe_b_group = (const float*)d_in[24]; const float* moe_w_expert = (const float*)d_in[25]; const float* moe_b_expert = (const float*)d_in[26];
    unsigned char* ws = (unsigned char*)d_ws;
    hipMemsetAsync(ws + WS_CTL, 0, CTL_ZERO_BYTES, stream);
    Args a{};
    for (int i = 0; i < 30; ++i) a.in[i] = (const float*)d_in[i];
    a.out = (float*)d_out; a.ws = ws;
    int n_launch = 0;
    auto run = [&](int lo, int hi) { a.ph_lo = lo; a.ph_hi = hi; a.li = n_launch++; hipLaunchKernelGGL(mega, dim3(grid), dim3(NWAVES * 64), LDS_BYTES, stream, a); };
    float* x = (float*)d_out;
    int* ctl = (int*)(ws + WS_CTL);
    float* mod = (float*)(ws + WS_MOD);
    int* slot_e = (int*)(ws + WS_TAB); int* slot_pos = slot_e + 2 * T; int* slot_of = slot_pos + 2 * T; float* slot_w = (float*)(slot_of + 2 * T);
    bf16* hb = (bf16*)(ws + WS_HB); float* y = (float*)(ws + WS_Y);
    bf16* projb = (bf16*)(ws + WS_R1); bf16* mixb = (bf16*)(ws + WS_R2);
    bf16* upA = (bf16*)(ws + WS_R1 + 80 * MiB); bf16* quk = (bf16*)(ws + WS_R1 + 92 * MiB); bf16* Kr = (bf16*)(ws + WS_R1 + 150 * MiB);
    float* gq = (float*)(ws + WS_R2 + 48 * MiB); float* gk = gq + (size_t)T * 512; float* gv = gk + (size_t)T * 512; float* gbeta = gv + (size_t)T * 512; float* gla = gbeta + (size_t)T * 8;
    bf16* Xp = (bf16*)(ws + WS_R1); float* Yp = (float*)(ws + WS_R2);
    int* cnt = ctl + CW_CNT; int* n_tiles = ctl + CW_NTILES; int* tile_expert = ctl + CW_TEXP;

    const size_t nTD = (size_t)T * D;
    run(0, 1);
    hipLaunchKernelGGL(k_copy, dim3((unsigned)((nTD + 255) / 256)), dim3(256), 0, stream, x_in, x, nTD);
    hipLaunchKernelGGL(k_mod, dim3(DEPTH * 6 * D / 256), dim3(256), 0, stream, c, ada_w, ada_b, mod);
    for (int layer = 0; layer < DEPTH; ++layer) {
        const float* mod_l = mod + (size_t)layer * NB * 6 * D;
        const int i = layer / 2, pb = 1 + layer * 16;
        hipLaunchKernelGGL(k_modulate, dim3((unsigned)(nTD / 256)), dim3(256), 0, stream, x, mod_l, 0, hb);
        run(pb, pb + 1);
        if (layer % 2 == 0) {
            hipLaunchKernelGGL(k_mla_norm, dim3(T / 4), dim3(256), 0, stream, projb, upA);
            run(pb + 1, pb + 2);
            run(pb + 2, pb + 3);
            hipLaunchKernelGGL(k_mla_rope, dim3(T * 144 / 256), dim3(256), 0, stream, quk, projb, positions, Kr);
            run(pb + 3, pb + 4);
        } else {
            hipLaunchKernelGGL(k_ret_rope, dim3(T * 1024 / 256), dim3(256), 0, stream, projb, positions);
            run(pb + 1, pb + 2);
            run(pb + 3, pb + 4);
        }
        run(pb + 4, pb + 5);
        hipLaunchKernelGGL(k_ln, dim3(T / 4), dim3(256), 0, stream, x, y, mod_l, 0, ln_mix_g + layer * D, ln_mix_b + layer * D, (const float*)nullptr, (const int*)nullptr, (const float*)nullptr);
        hipLaunchKernelGGL(k_modulate, dim3((unsigned)(nTD / 256)), dim3(256), 0, stream, x, mod_l, 1, hb);
        hipLaunchKernelGGL(k_zero_int, dim3(1), dim3(64), 0, stream, cnt, 64);
        hipLaunchKernelGGL(k_router, dim3(T / 4), dim3(256), 0, stream, x, mod_l, moe_w_group + (size_t)layer * D * NG, moe_b_group + layer * NG,
                           moe_w_expert + (size_t)layer * D * NE, moe_b_expert + layer * NE, slot_e, slot_w, slot_pos, cnt);
        hipLaunchKernelGGL(k_gather, dim3(2 * T / 4), dim3(256), 0, stream, hb, slot_e, slot_pos, cnt, Xp, slot_of, tile_expert, n_tiles);
        run(pb + 7, pb + 9);
        hipLaunchKernelGGL(k_ln, dim3(T / 4), dim3(256), 0, stream, x, (const float*)nullptr, mod_l, 1, ln_ffn_g + layer * D, ln_ffn_b + layer * D, Yp, slot_of, slot_w);
    }
}
```

```cpp
#include <hip/hip_runtime.h>
#include <cstdio>
#include <cstdint>
namespace pg8 {
#define PG8_LAS __attribute__((address_space(3)))
typedef unsigned short bf16_t;
typedef short bf16x8 __attribute__((ext_vector_type(8)));
typedef float f32x4 __attribute__((ext_vector_type(4)));
typedef unsigned u32x4 __attribute__((ext_vector_type(4)));
constexpr int BM = 256, BK = 64, HALF = 128, HTB = HALF * BK * 2  , STAGE_BYTES = 8 * HTB, NXCD = 8, WGM = 8;

__host__ __device__ __forceinline__ int lds_byte(int r, int c) { const int st = (r >> 4) * 2 + (c >> 5), rr = r & 15, cc = c & 31, ob = rr * 64 + cc * 2; return st * 1024 + (ob ^ (((ob >> 9) & 1) << 5)); }
__host__ __device__ __forceinline__ void stage_rc(int b, int& R, int& C) { const int st = b / 1024, sb = b % 1024, swz = sb ^ (((sb >> 9) & 1) << 5); R = (st >> 1) * 16 + swz / 64; C = (st & 1) * 32 + (swz % 64) / 2; }
__host__ __device__ __forceinline__ int perm32(int rho) { const int n = rho >> 4, i = rho & 15; return 8 * (i >> 2) + 4 * n + (i & 3); }

struct Unit { int pm, pn; };
struct Gemm { const bf16_t* A; const bf16_t* Bt; int M, N, K; };

struct StaticOrder {
    int nM, nN, nwg, G, c;
    __host__ __device__ void init(int M, int N, int G_, int c_) { nM = M / BM; nN = N / BM; nwg = nM * nN; G = G_; c = c_; }
    __host__ __device__ bool next(int i, Unit& u) const {
        const long L = (long)i * G + c; if (L >= nwg) return false;
        int wgid = (int)L; { const int q = nwg / NXCD, r = nwg % NXCD, xcd = wgid % NXCD, off = wgid / NXCD; wgid = (xcd < r ? xcd * (q + 1) : r * (q + 1) + (xcd - r) * q) + off; }
        const int nig = WGM * nN, gid = wgid / nig, fm = gid * WGM, gsz = (nM - fm) < WGM ? (nM - fm) : WGM;
        u.pm = fm + ((wgid % nig) % gsz); u.pn = (wgid % nig) / gsz; return true;
    }
    __device__ __forceinline__ void a_ready(const Unit&) const {}
    __device__ __forceinline__ void done(const Unit&) const {}
};

__device__ __forceinline__ unsigned cvt_pk_bf16(float lo, float hi) { unsigned r; asm volatile("v_cvt_pk_bf16_f32 %0, %1, %2" : "=v"(r) : "v"(lo), "v"(hi)); return r; }
typedef float f32x2 __attribute__((ext_vector_type(2)));
typedef unsigned u32x2 __attribute__((ext_vector_type(2)));
struct EpiF32 {
    static constexpr bool PERM = false, AFTER_DRAIN = false;
    float* C; int ldc; int pn_mask;
    __device__ __forceinline__ void operator()(const f32x4 (&acc)[2][2][4][2], const Unit& u, int wr, int wc, int fr, int fq) const {
        const int row0 = u.pm * BM + wr * 64 + fr, col0 = (u.pn & pn_mask) * BM + wc * 32 + 4 * fq;
#pragma unroll
        for (int ai = 0; ai < 2; ++ai)
#pragma unroll
            for (int m = 0; m < 4; ++m) { float* rowp = C + (size_t)(row0 + ai * HALF + m * 16) * ldc + col0;
#pragma unroll
                for (int bj = 0; bj < 2; ++bj)
#pragma unroll
                    for (int n = 0; n < 2; ++n) *(f32x4*)(rowp + bj * HALF + n * 16) = acc[ai][bj][m][n]; }
    }
};
struct EpiB16 {
    static constexpr bool PERM = false, AFTER_DRAIN = false;
    bf16_t* O; int ldc; int pn_mask;
    __device__ __forceinline__ void operator()(const f32x4 (&acc)[2][2][4][2], const Unit& u, int wr, int wc, int fr, int fq) const {
        const int row0 = u.pm * BM + wr * 64 + fr, col0 = (u.pn & pn_mask) * BM + wc * 32 + 4 * fq;
#pragma unroll
        for (int ai = 0; ai < 2; ++ai)
#pragma unroll
            for (int m = 0; m < 4; ++m) { bf16_t* rowp = O + (size_t)(row0 + ai * HALF + m * 16) * ldc + col0;
#pragma unroll
                for (int bj = 0; bj < 2; ++bj)
#pragma unroll
                    for (int n = 0; n < 2; ++n) { const f32x4 v = acc[ai][bj][m][n]; u32x2 w; w.x = cvt_pk_bf16(v[0], v[1]); w.y = cvt_pk_bf16(v[2], v[3]); *(u32x2*)(rowp + bj * HALF + n * 16) = w; } }
    }
};
struct EpiSiluMul {
    static constexpr bool PERM = false, AFTER_DRAIN = false;
    bf16_t* O; int ldc;
    __device__ __forceinline__ void operator()(const f32x4 (&acc)[2][2][4][2], const Unit& u, int wr, int wc, int fr, int fq) const {
        const int row0 = u.pm * BM + wr * 64 + fr, f0 = ((u.pn & 3) * 8 + wc) * 16 + 4 * fq;
#pragma unroll
        for (int ai = 0; ai < 2; ++ai)
#pragma unroll
            for (int m = 0; m < 4; ++m) { bf16_t* rowp = O + (size_t)(row0 + ai * HALF + m * 16) * ldc + f0;
#pragma unroll
                for (int bj = 0; bj < 2; ++bj) { const f32x4 g = acc[ai][bj][m][0], up = acc[ai][bj][m][1]; f32x4 r;
#pragma unroll
                    for (int j = 0; j < 4; ++j) r[j] = g[j] * __builtin_amdgcn_rcpf(1.f + __expf(-g[j])) * up[j];
                    u32x2 w; w.x = cvt_pk_bf16(r[0], r[1]); w.y = cvt_pk_bf16(r[2], r[3]); *(u32x2*)(rowp + bj * 64) = w; } }
    }
};
struct EpiQuk {
    static constexpr bool PERM = false, AFTER_DRAIN = false;
    bf16_t* O; int ldc; const float* csm;
    __device__ __forceinline__ void operator()(const f32x4 (&acc)[2][2][4][2], const Unit& u, int wr, int wc, int fr, int fq) const {
        const int row0 = u.pm * BM + wr * 64 + fr; const float QS = 0.14724270f;
#pragma unroll
        for (int ai = 0; ai < 2; ++ai)
#pragma unroll
            for (int m = 0; m < 4; ++m) { const int row = row0 + ai * HALF + m * 16;
#pragma unroll
                for (int bj = 0; bj < 2; ++bj) { const int G32 = u.pn * 8 + bj * 4 + wc;
                    f32x4 v0 = acc[ai][bj][m][0], v1 = acc[ai][bj][m][1];
                    if (G32 < 24) {
                        if (G32 % 3 == 2) { const float* cs = csm + ((size_t)row * 16 + 4 * fq) * 2; const f32x4 c0 = *(const f32x4*)cs, c1 = *(const f32x4*)(cs + 4);
                            const f32x4 cc = {c0[0], c0[2], c1[0], c1[2]}, ss = {c0[1], c0[3], c1[1], c1[3]};
                            const f32x4 o1 = v0 * cc - v1 * ss, o2 = v0 * ss + v1 * cc; v0 = o1; v1 = o2; }
                        v0 = v0 * QS; v1 = v1 * QS;
                    }
                    bf16_t* p = O + (size_t)row * ldc + G32 * 32 + 4 * fq;
                    u32x2 w0; w0.x = cvt_pk_bf16(v0[0], v0[1]); w0.y = cvt_pk_bf16(v0[2], v0[3]); *(u32x2*)p = w0;
                    u32x2 w1; w1.x = cvt_pk_bf16(v1[0], v1[1]); w1.y = cvt_pk_bf16(v1[2], v1[3]); *(u32x2*)(p + 16) = w1; } }
    }
};
struct EpiRet {
    static constexpr bool PERM = false, AFTER_DRAIN = false;
    bf16_t* O; int ldc; const float* csr;
    __device__ __forceinline__ void operator()(const f32x4 (&acc)[2][2][4][2], const Unit& u, int wr, int wc, int fr, int fq) const {
        const int row0 = u.pm * BM + wr * 64 + fr;
#pragma unroll
        for (int ai = 0; ai < 2; ++ai)
#pragma unroll
            for (int m = 0; m < 4; ++m) { const int row = row0 + ai * HALF + m * 16;
#pragma unroll
                for (int bj = 0; bj < 2; ++bj) { const int G32 = u.pn * 8 + bj * 4 + wc;
                    f32x4 v0 = acc[ai][bj][m][0], v1 = acc[ai][bj][m][1];
                    if (G32 < 64) { const float* cs = csr + ((size_t)row * 64 + 16 * (G32 & 3) + 4 * fq) * 2; const f32x4 c0 = *(const f32x4*)cs, c1 = *(const f32x4*)(cs + 4);
                        const f32x4 cc = {c0[0], c0[2], c1[0], c1[2]}, ss = {c0[1], c0[3], c1[1], c1[3]};
                        f32x4 o1 = v0 * cc - v1 * ss, o2 = v0 * ss + v1 * cc;
                        if (G32 < 32) { o1 = o1 * 0.08838834764831845f; o2 = o2 * 0.08838834764831845f; }
                        v0 = o1; v1 = o2; }
                    bf16_t* p = O + (size_t)row * ldc + G32 * 32 + 4 * fq;
                    u32x2 w0; w0.x = cvt_pk_bf16(v0[0], v0[1]); w0.y = cvt_pk_bf16(v0[2], v0[3]); *(u32x2*)p = w0;
                    u32x2 w1; w1.x = cvt_pk_bf16(v1[0], v1[1]); w1.y = cvt_pk_bf16(v1[2], v1[3]); *(u32x2*)(p + 16) = w1; } }
    }
};
struct GroupedOrder {
    const int* tile_expert; int n_units, G, c;
    __device__ bool next(int i, Unit& u) const { const int L = i * G + c; if (L >= n_units) return false; const int rt = L >> 2; u.pm = rt; u.pn = tile_expert[rt] * 4 + (L & 3); return true; }
    __device__ __forceinline__ void a_ready(const Unit&) const {}
    __device__ __forceinline__ void done(const Unit&) const {}
};
template <class Epi, class Sched, bool ALIGN_EPI = false, bool SP2 = false>
__device__ __forceinline__ void gemm_phase(PG8_LAS unsigned char* lds, const Gemm g, const Sched& S, const Epi& E) {
    int tid_ = threadIdx.x; asm volatile("" : "+v"(tid_));
    const int tid = tid_, wid = __builtin_amdgcn_readfirstlane(tid >> 6), lane = tid & 63, wr = wid >> 2, wc = wid & 3, fr = lane & 15, fq = lane >> 4;
    int K_ = g.K; asm volatile("" : "+s"(K_));
    const int K = K_, nt = K / BK;
    unsigned voffA[2], voffB[2];
#pragma unroll
    for (int i = 0; i < 2; ++i) { int R, C; stage_rc(tid * 16 + i * 8192, R, C); const int Rb = Epi::PERM ? ((R & ~31) + perm32(R & 31)) : R;
        voffA[i] = (unsigned)(R * K + C) * 2u; voffB[i] = (unsigned)(Rb * K + C) * 2u; }
    const size_t kstep = (size_t)(BK * 2);
    const size_t hstep = (size_t)HALF * K * 2;
    const size_t tstep = 2 * hstep;
    const unsigned ldsw = (unsigned)wid * 1024u;
    const int aoff = lds_byte(wr * 64 + fr, fq * 8), boff = lds_byte(wc * 32 + fr, fq * 8);
#define PG8_SA(b, h) (((b) * 2 + (h)) * HTB)
#define PG8_SB(b, h) ((4 + (b) * 2 + (h)) * HTB)
#define PG8_STAGE(bufoff, gbase, voff) do { _Pragma("unroll") for (int _i = 0; _i < 2; ++_i) \
        __builtin_amdgcn_global_load_lds((const unsigned*)((const char*)(gbase) + (voff)[_i]), (PG8_LAS unsigned*)(lds + (bufoff) + ldsw + _i * 8192), 16, 0, 0); } while (0)
#define PG8_LDA(dst, b, h) do { _Pragma("unroll") for (int m = 0; m < 4; ++m) _Pragma("unroll") for (int k = 0; k < 2; ++k) dst[m][k] = *(const PG8_LAS bf16x8*)(lds + PG8_SA(b, h) + aoff + m * 2048 + k * 1024); } while (0)
#define PG8_LDB(dst, b, h) do { _Pragma("unroll") for (int n = 0; n < 2; ++n) _Pragma("unroll") for (int k = 0; k < 2; ++k) dst[n][k] = *(const PG8_LAS bf16x8*)(lds + PG8_SB(b, h) + boff + n * 2048 + k * 1024); } while (0)
#define PG8_MMA(ai, bj, At, Bt) do { __builtin_amdgcn_s_setprio(1); _Pragma("unroll") for (int m = 0; m < 4; ++m) _Pragma("unroll") for (int n = 0; n < 2; ++n) _Pragma("unroll") for (int k = 0; k < 2; ++k) \
        acc[ai][bj][m][n] = __builtin_amdgcn_mfma_f32_16x16x32_bf16(Bt[n][k], At[m][k], acc[ai][bj][m][n], 0, 0, 0); __builtin_amdgcn_s_setprio(0); } while (0)
#define PG8_WAIT_V(n) asm volatile("s_waitcnt vmcnt(" #n ")" ::: "memory")
#define PG8_WAIT_L(n) asm volatile("s_waitcnt lgkmcnt(" #n ")" ::: "memory")
#define PG8_BAR __builtin_amdgcn_s_barrier()
#define PG8_SCHED __builtin_amdgcn_sched_barrier(0)
    Unit cur, nxt; int ui = 0;
    if (!S.next(0, cur)) return;
    f32x4 acc[2][2][4][2];
#pragma unroll
    for (int a = 0; a < 2; ++a)
#pragma unroll
        for (int b = 0; b < 2; ++b)
#pragma unroll
            for (int m = 0; m < 4; ++m)
#pragma unroll
                for (int n = 0; n < 2; ++n) acc[a][b][m][n] = (f32x4){0.f, 0.f, 0.f, 0.f};
    bf16x8 At[4][2], B0[2][2], B1[2][2];
    const char* cA = (const char*)g.A + (size_t)cur.pm * tstep; const char* cB = (const char*)g.Bt + (size_t)cur.pn * tstep;
    S.a_ready(cur);
    if constexpr (SP2) {
        PG8_STAGE(PG8_SB(0, 0), cB, voffB); PG8_STAGE(PG8_SB(0, 1), cB + hstep, voffB); PG8_STAGE(PG8_SA(0, 0), cA, voffA); PG8_STAGE(PG8_SA(0, 1), cA + hstep, voffA);
        if (wr == 1) PG8_BAR;
        PG8_WAIT_V(2); PG8_BAR;
        PG8_STAGE(PG8_SB(1, 0), cB + kstep, voffB); PG8_STAGE(PG8_SA(1, 0), cA + kstep, voffA); PG8_STAGE(PG8_SB(1, 1), cB + hstep + kstep, voffB);
        PG8_WAIT_V(6); PG8_BAR;
    } else {
        PG8_STAGE(PG8_SB(0, 0), cB, voffB); PG8_STAGE(PG8_SA(0, 0), cA, voffA); PG8_STAGE(PG8_SB(0, 1), cB + hstep, voffB); PG8_STAGE(PG8_SA(0, 1), cA + hstep, voffA);
        if (wr == 1) PG8_BAR;
        PG8_WAIT_V(4); PG8_BAR;
        PG8_STAGE(PG8_SB(1, 0), cB + kstep, voffB); PG8_STAGE(PG8_SA(1, 0), cA + kstep, voffA); PG8_STAGE(PG8_SB(1, 1), cB + hstep + kstep, voffB);
        PG8_WAIT_V(6); PG8_BAR;
    }
    for (;;) {
        const bool has_next = S.next(ui + 1, nxt);
        const char* nA = has_next ? (const char*)g.A + (size_t)nxt.pm * tstep : cA; const char* nB = has_next ? (const char*)g.Bt + (size_t)nxt.pn * tstep : cB;
        for (int t = 0; t < nt; t += 2) {
            const bool last = (t == nt - 2);
            const char* a1 = cA + (size_t)(t + 1) * kstep;
            const char* a2 = last ? nA : cA + (size_t)(t + 2) * kstep; const char* b2 = last ? nB : cB + (size_t)(t + 2) * kstep;
            const char* a3 = a2 + kstep; const char* b3 = b2 + kstep;
            if (last && has_next) S.a_ready(nxt);
            if constexpr (SP2) {
            PG8_LDB(B0, 0, 0); PG8_LDB(B1, 0, 1); PG8_SCHED; PG8_LDA(At, 0, 0); PG8_STAGE(PG8_SA(1, 1), a1 + hstep, voffA);
            PG8_WAIT_V(8); PG8_WAIT_L(0); PG8_BAR; PG8_MMA(0, 0, At, B0); PG8_MMA(0, 1, At, B1); PG8_BAR; PG8_SCHED;
            PG8_LDA(At, 0, 1); PG8_STAGE(PG8_SB(0, 0), b2, voffB); PG8_STAGE(PG8_SB(0, 1), b2 + hstep, voffB); PG8_STAGE(PG8_SA(0, 0), a2, voffA);
            PG8_WAIT_V(8); PG8_WAIT_L(0); PG8_BAR; PG8_MMA(1, 0, At, B0); PG8_MMA(1, 1, At, B1); PG8_BAR; PG8_SCHED;
            PG8_LDB(B0, 1, 0); PG8_LDB(B1, 1, 1); PG8_SCHED; PG8_LDA(At, 1, 0); PG8_STAGE(PG8_SA(0, 1), a2 + hstep, voffA);
            PG8_WAIT_V(8); PG8_WAIT_L(0); PG8_BAR; PG8_MMA(0, 0, At, B0); PG8_MMA(0, 1, At, B1); PG8_BAR; PG8_SCHED;
            PG8_LDA(At, 1, 1); PG8_STAGE(PG8_SB(1, 0), b3, voffB); PG8_STAGE(PG8_SB(1, 1), b3 + hstep, voffB); PG8_STAGE(PG8_SA(1, 0), a3, voffA);
            PG8_WAIT_V(8); PG8_WAIT_L(0); PG8_BAR; PG8_MMA(1, 0, At, B0); PG8_MMA(1, 1, At, B1); PG8_BAR; PG8_SCHED;
            } else {
            PG8_LDB(B0, 0, 0); PG8_SCHED; PG8_LDA(At, 0, 0); PG8_STAGE(PG8_SA(1, 1), a1 + hstep, voffA);
            PG8_WAIT_L(8); PG8_BAR; PG8_WAIT_L(0); PG8_MMA(0, 0, At, B0); PG8_BAR; PG8_SCHED;
            PG8_LDB(B1, 0, 1); PG8_STAGE(PG8_SB(0, 0), b2, voffB);
            PG8_BAR; PG8_WAIT_L(0); PG8_MMA(0, 1, At, B1); PG8_BAR;
            PG8_LDA(At, 0, 1); PG8_STAGE(PG8_SA(0, 0), a2, voffA);
            PG8_BAR; PG8_WAIT_L(0); PG8_MMA(1, 0, At, B0); PG8_BAR; PG8_SCHED;
            PG8_STAGE(PG8_SB(0, 1), b2 + hstep, voffB);
            PG8_WAIT_V(6); PG8_BAR; PG8_MMA(1, 1, At, B1); PG8_BAR;
            PG8_LDB(B0, 1, 0); PG8_SCHED; PG8_LDA(At, 1, 0); PG8_STAGE(PG8_SA(0, 1), a2 + hstep, voffA);
            PG8_WAIT_L(8); PG8_BAR; PG8_WAIT_L(0); PG8_MMA(0, 0, At, B0); PG8_BAR; PG8_SCHED;
            PG8_LDB(B1, 1, 1); PG8_STAGE(PG8_SB(1, 0), b3, voffB);
            PG8_BAR; PG8_WAIT_L(0); PG8_MMA(0, 1, At, B1); PG8_BAR;
            PG8_LDA(At, 1, 1); PG8_STAGE(PG8_SA(1, 0), a3, voffA);
            PG8_BAR; PG8_WAIT_L(0); PG8_MMA(1, 0, At, B0); PG8_BAR; PG8_SCHED;
            PG8_STAGE(PG8_SB(1, 1), b3 + hstep, voffB);
            PG8_WAIT_V(6); PG8_BAR; PG8_MMA(1, 1, At, B1); PG8_BAR;
            }
        }
        if constexpr (ALIGN_EPI) { if (wr == 0) PG8_BAR; }
        if constexpr (!Epi::AFTER_DRAIN) { E(acc, cur, wr, wc, fr, fq); S.done(cur); }
        if (!has_next) break;
#pragma unroll
        for (int a = 0; a < 2; ++a)
#pragma unroll
            for (int b = 0; b < 2; ++b)
#pragma unroll
                for (int m = 0; m < 4; ++m)
#pragma unroll
                    for (int n = 0; n < 2; ++n) acc[a][b][m][n] = (f32x4){0.f, 0.f, 0.f, 0.f};
        cur = nxt; cA = nA; cB = nB; ++ui;
        if constexpr (ALIGN_EPI) { if (wr == 1) PG8_BAR; }
    }
    PG8_WAIT_V(0);
    if constexpr (!ALIGN_EPI) { if (wr == 0) PG8_BAR; }
    PG8_BAR;
    if constexpr (Epi::AFTER_DRAIN) { E.fused(acc, cur, wr, wc, fr, fq, lds, wid, lane); S.done(cur); }
#undef PG8_SA
#undef PG8_SB
#undef PG8_STAGE
#undef PG8_LDA
#undef PG8_LDB
#undef PG8_MMA
#undef PG8_WAIT_V
#undef PG8_WAIT_L
#undef PG8_BAR
#undef PG8_SCHED
}
}
#define PG8_SP2 true
#define PG8_ALIGN true
#define GAS __attribute__((address_space(1)))
#define LAS __attribute__((address_space(3)))
typedef unsigned short bf16;
typedef unsigned v4u __attribute__((ext_vector_type(4)));
typedef float f32x4 __attribute__((ext_vector_type(4)));
typedef short bf16x8 __attribute__((ext_vector_type(8)));
typedef GAS unsigned gu32;
typedef GAS unsigned long long gu64;
#define RLX_AGENT __ATOMIC_RELAXED, __HIP_MEMORY_SCOPE_AGENT
#define LDS_WAIT() asm volatile("s_waitcnt lgkmcnt(0)" ::: "memory")
#define VM_WAIT() asm volatile("s_waitcnt vmcnt(0)" ::: "memory")
__device__ __forceinline__ unsigned long long rt() { return __builtin_amdgcn_s_memrealtime(); }
__device__ __forceinline__ unsigned f2bf(float f) { unsigned u = __builtin_bit_cast(unsigned, f); return (u + 0x7fffu + ((u >> 16) & 1u)) >> 16; }
__device__ __forceinline__ unsigned pk2(float lo, float hi) { return f2bf(lo) | (f2bf(hi) << 16); }

#define XB_TMO      128
#define XB_XCNT(j)  (256  + 64 * (j))
#define XB_XSUB(j)  (1280 + 64 * (j))
#define XB_XGEN(j)  (2304 + 64 * (j))
#define XB_TOP      3328
#define XB_TOPGEN   3392
#define XCD_BAR_WORDS 3456
#define XB_SPIN_CAP (1u << 18)

__device__ __forceinline__ unsigned xb_ld(unsigned* p)              { return __hip_atomic_load(p, __ATOMIC_RELAXED, __HIP_MEMORY_SCOPE_AGENT); }
__device__ __forceinline__ unsigned xb_add(unsigned* p, unsigned v) { return __hip_atomic_fetch_add(p, v, __ATOMIC_RELAXED, __HIP_MEMORY_SCOPE_AGENT); }
__device__ __forceinline__ unsigned xb_xcc_id() { return (unsigned)__builtin_amdgcn_s_getreg((3 << 11) | 20) & 0xFu; }
#define XB_SPIN(cond, bar) do { unsigned _sp = 0; while (cond) { __builtin_amdgcn_s_sleep(1); \
    if ((++_sp & 255u) == 0u) { if (xb_ld(&(bar)[XB_TMO])) break; if (_sp > XB_SPIN_CAP) { atomicAdd(&(bar)[XB_TMO], 1u); break; } } } } while (0)

struct XcdBarrier {
    unsigned* bar; unsigned x;
    volatile LAS unsigned* st;
};

__device__ __forceinline__ XcdBarrier xcd_barrier_post(unsigned* bar, volatile LAS unsigned* st) {
    XcdBarrier b; b.bar = bar; b.x = xb_xcc_id(); b.st = st;
    if (threadIdx.x == 0) (void)xb_add(&bar[XB_XCNT(b.x)], 1u);
    return b;
}
__device__ __forceinline__ void xcd_barrier_complete(unsigned* bar, unsigned x, unsigned& nloc, unsigned& nx) {
    const unsigned G = gridDim.x * gridDim.y * gridDim.z;
    unsigned sum, cnt, mine, sp = 0u;
    for (;;) {
        sum = 0u; cnt = 0u; mine = 0u;
#pragma unroll
        for (unsigned j = 0; j < 16; ++j) { const unsigned c = xb_ld(&bar[XB_XCNT(j)]); sum += c; cnt += (c > 0u) ? 1u : 0u; mine = (j == x) ? c : mine; }
        if (sum == G) break;
        __builtin_amdgcn_s_sleep(1);
        if ((++sp & 255u) == 0u) { if (xb_ld(&bar[XB_TMO])) break; if (sp > XB_SPIN_CAP) { atomicAdd(&bar[XB_TMO], 1u); break; } }
    }
    nloc = mine > 0u ? mine : 1u; nx = cnt > 0u ? cnt : 1u;
}

__device__ __forceinline__ void xcd_barrier(const XcdBarrier& b) {
    asm volatile("s_waitcnt vmcnt(0)" ::: "memory");
    __syncthreads();
    if (threadIdx.x == 0) {
        unsigned* bar = b.bar;
        __builtin_amdgcn_s_waitcnt(0);
        unsigned nloc = b.st[0], nx = b.st[1];
        if (nloc == 0u) { xcd_barrier_complete(bar, b.x, nloc, nx); b.st[0] = nloc; b.st[1] = nx; }
        const unsigned old = xb_add(&bar[XB_XSUB(b.x)], 1u);
        const unsigned gen = old / nloc;
        if (old + 1u == (gen + 1u) * nloc) {
            __builtin_amdgcn_fence(__ATOMIC_RELEASE, "agent");
            asm volatile("s_waitcnt vmcnt(0)" ::: "memory");
            const unsigned og = xb_add(&bar[XB_TOP], 1u);
            const unsigned tg = og / nx;
            if (og + 1u == (tg + 1u) * nx) xb_add(&bar[XB_TOPGEN], 1u);
            else XB_SPIN(xb_ld(&bar[XB_TOPGEN]) == tg, bar);
            __builtin_amdgcn_fence(__ATOMIC_ACQUIRE, "agent");
            xb_add(&bar[XB_XGEN(b.x)], 1u);
            asm volatile("s_waitcnt vmcnt(0)" ::: "memory");
        } else {
            XB_SPIN(xb_ld(&bar[XB_XGEN(b.x)]) == gen, bar);
            __builtin_amdgcn_fence(__ATOMIC_ACQUIRE, "agent");
            asm volatile("s_waitcnt vmcnt(0)" ::: "memory");
        }
    }
    __syncthreads();
}

namespace {
constexpr int D = 1024, NB = 4, SEQ = 4096, T = NB * SEQ, DEPTH = 4;
constexpr int MLA_COLS = 416, HY_IN = 2480, HY_LD = 2560, UP_K = 384, UP_N = 1792;
constexpr int RET_IN = 6144, RET_MIX = 2048;
constexpr int NG = 4, NE = 32, FF = 512;
constexpr int XP_ROWS = 2 * T + NE * 256;
constexpr float LN_EPS = 1e-5f, RMS_EPS = 1e-6f;
constexpr float ALPHA = 1.681792830507429f;
constexpr size_t MiB = 1u << 20;
constexpr size_t WS_CTL = 0, CTL_ZERO_BYTES = 1 * MiB;
constexpr size_t WS_MOD = 1 * MiB, WS_TAB = 1 * MiB + 512 * 1024;
constexpr size_t WS_HB = 2 * MiB, WS_Y = 34 * MiB;
constexpr size_t WS_WIN = 98 * MiB, WS_WUP = 108 * MiB, WS_WOUT = 111 * MiB, WS_RIN = 115 * MiB, WS_ROUT = 139 * MiB, WS_WGU = 147 * MiB, WS_WD = 403 * MiB;
constexpr size_t WS_R1 = 531 * MiB, WS_R2 = 723 * MiB, WS_END = 883 * MiB;
constexpr size_t WS_UPA = WS_R1 + 80 * MiB, WS_QUK = WS_R1 + 92 * MiB, WS_KR = WS_R1 + 150 * MiB, WS_HID = WS_R1 + 80 * MiB, WS_ST = WS_R2 + 64 * MiB, WS_GD = WS_R2 + 32 * MiB, WS_GL = WS_R2 + 112 * MiB;
constexpr size_t WS_CSM = 883 * MiB, WS_CSR = 885 * MiB, WS_END2 = 893 * MiB, WS_TAB_SE = WS_TAB, WS_TAB_SP = WS_TAB + 128 * 1024, WS_TAB_SO = WS_TAB + 256 * 1024, WS_TAB_SW = WS_TAB + 384 * 1024;
constexpr int CW_TMO = 0, CW_CODE = 1, CW_CNT = 64, CW_NTILES = 128, CW_TEXP = 192  , CW_AQ = 512, CW_BAR = 4096;
constexpr int RING_OFF = 0, RING_BYTES = 131072, LDSCTL_OFF = RING_BYTES, MISC_OFF = LDSCTL_OFF + 320, LDS_BYTES = 147456;
constexpr int NWAVES = 8;

__device__ __forceinline__ float silu_f(float x) { return x / (1.f + __expf(-x)); }
__device__ __forceinline__ float bf2f(bf16 v) { return __uint_as_float(((unsigned)v) << 16); }
__device__ __forceinline__ bf16 f2b(float f) { return (bf16)f2bf(f); }

struct Args { const float* in[30]; float* out; unsigned char* ws; int ph_lo, ph_hi, li, pad; };
struct Frame {
    LAS unsigned char* lds; volatile LAS unsigned* MISC; gu32* ctl;
    int tid, lane, wave, vcu, G;
};
template <class F> __device__ __forceinline__ void tr_item(F src, int K, bf16* WT, int k0, int n0, LAS float* scr, int lane) {
#pragma unroll 8
    for (int i = 0; i < 32; ++i) { const int kk = 2 * i + (lane >> 5); scr[kk * 33 + (lane & 31)] = src(n0 + (lane & 31), k0 + kk); }
    LDS_WAIT(); asm volatile("" ::: "memory");
    const int c = lane & 7;
#pragma unroll
    for (int j = 0; j < 4; ++j) { const int n = (lane >> 3) + 8 * j; const LAS float* s = scr + (8 * c) * 33 + n;
        v4u o; o.x = pk2(s[0 * 33], s[1 * 33]); o.y = pk2(s[2 * 33], s[3 * 33]); o.z = pk2(s[4 * 33], s[5 * 33]); o.w = pk2(s[6 * 33], s[7 * 33]);
        *(GAS v4u*)(WT + (size_t)(n0 + n) * K + k0 + 8 * c) = o; }
    LDS_WAIT(); asm volatile("" ::: "memory");
}
__device__ __forceinline__ void p0_weights(Frame& F, const Args& a) {
    LAS float* scr = (LAS float*)(F.lds + RING_OFF + F.wave * 16384);
    int tid_ = threadIdx.x; asm volatile("" : "+v"(tid_));
    const int gw = F.vcu * NWAVES + F.wave, NGW = F.G * NWAVES, lane = tid_ & 63;
    unsigned char* ws = a.ws;
    constexpr int I_WIN = (D / 64) * (HY_LD / 32), I_WUP = (UP_K / 64) * (UP_N / 32), I_WOUT = (D / 64) * (D / 32), I_RIN = (D / 64) * (RET_IN / 32), I_ROUT = (RET_MIX / 64) * (D / 32);
    constexpr int I_GU = (D / 64) * (1024 / 32), I_D = (FF / 64) * (D / 32);
    constexpr int N_SMALL = 2 * (I_WIN + I_WUP + I_WOUT + I_RIN + I_ROUT), N_GU = DEPTH * NE * I_GU, N_D = DEPTH * NE * I_D;
    for (int it = gw; it < N_SMALL + N_GU + N_D; it += NGW) {
        int r = it;
        if (r < N_SMALL) {
            const int i = r & 1; r >>= 1;
            if (r < I_WIN) { const float* W = a.in[9] + (size_t)i * D * HY_IN; const int nblk = HY_LD / 32;
                tr_item([=](int n, int k) { return n < HY_IN ? W[(size_t)k * HY_IN + n] : 0.f; }, D, (bf16*)(ws + WS_WIN) + (size_t)i * HY_LD * D, 64 * (r / nblk), 32 * (r % nblk), scr, lane); continue; }
            r -= I_WIN;
            if (r < I_WUP) { const float* Wq = a.in[11] + (size_t)i * 256 * 768; const float* Wkv = a.in[13] + (size_t)i * 128 * 1024; const float* gq = a.in[10] + i * 256; const float* gkv = a.in[12] + i * 128; const int nblk = UP_N / 32;
                tr_item([=](int n, int k) { return n < 768 ? (k < 256 ? gq[k] * Wq[(size_t)k * 768 + n] : 0.f) : (k >= 256 ? gkv[k - 256] * Wkv[(size_t)(k - 256) * 1024 + (n - 768)] : 0.f); },
                        UP_K, (bf16*)(ws + WS_WUP) + (size_t)i * UP_N * UP_K, 64 * (r / nblk), 32 * (r % nblk), scr, lane); continue; }
            r -= I_WUP;
            if (r < I_WOUT) { const float* W = a.in[18] + (size_t)i * D * D; const int nblk = D / 32;
                tr_item([=](int n, int k) { return W[(size_t)k * D + n]; }, D, (bf16*)(ws + WS_WOUT) + (size_t)i * D * D, 64 * (r / nblk), 32 * (r % nblk), scr, lane); continue; }
            r -= I_WOUT;
            if (r < I_RIN) { const float* W = a.in[19] + (size_t)i * D * RET_IN; const int nblk = RET_IN / 32;
                tr_item([=](int n, int k) { const int nn = n < 2048 ? ((n & ~127) + ((n & 16) ? 64 : 0) + 16 * ((n & 127) >> 5) + (n & 15)) : n; return W[(size_t)k * RET_IN + nn]; }, D, (bf16*)(ws + WS_RIN) + (size_t)i * RET_IN * D, 64 * (r / nblk), 32 * (r % nblk), scr, lane); continue; }
            r -= I_RIN;
            { const float* W = a.in[22] + (size_t)i * RET_MIX * D; const int nblk = D / 32;
                tr_item([=](int n, int k) { return W[(size_t)k * D + n]; }, RET_MIX, (bf16*)(ws + WS_ROUT) + (size_t)i * D * RET_MIX, 64 * (r / nblk), 32 * (r % nblk), scr, lane); continue; }
        }
        r -= N_SMALL;
        if (r < N_GU) { const int le = r / I_GU; r %= I_GU; const float* Wg = a.in[27] + (size_t)le * D * FF; const float* Wu = a.in[28] + (size_t)le * D * FF; const int nblk = 1024 / 32;
            tr_item([=](int n, int k) { const int G32 = n >> 5, t = n & 31; return t < 16 ? Wg[(size_t)k * FF + 16 * G32 + t] : Wu[(size_t)k * FF + 16 * G32 + t - 16]; },
                    D, (bf16*)(ws + WS_WGU) + (size_t)le * 1024 * D, 64 * (r / nblk), 32 * (r % nblk), scr, lane); continue; }
        r -= N_GU;
        { const int le = r / I_D; r %= I_D; const float* W = a.in[29] + (size_t)le * FF * D; const int nblk = D / 32;
            tr_item([=](int n, int k) { return W[(size_t)k * D + n]; }, FF, (bf16*)(ws + WS_WD) + (size_t)le * D * FF, 64 * (r / nblk), 32 * (r % nblk), scr, lane); }
    }
}

typedef short s16x4 __attribute__((ext_vector_type(4)));
typedef short v4i16_t __attribute__((ext_vector_type(4)));
__device__ __forceinline__ s16x4 lds_tr16(const LAS unsigned char* p) { return __builtin_bit_cast(s16x4, __builtin_amdgcn_ds_read_tr16_b64_v4i16((LAS v4i16_t*)p)); }
__device__ __forceinline__ f32x4 mfma16(bf16x8 a, bf16x8 b, f32x4 c) { return __builtin_amdgcn_mfma_f32_16x16x32_bf16(a, b, c, 0, 0, 0); }
__device__ __forceinline__ bf16x8 cat4(s16x4 a, s16x4 b) { return __builtin_shufflevector(a, b, 0, 1, 2, 3, 4, 5, 6, 7); }
__device__ __forceinline__ unsigned cvtpk(float lo, float hi) { typedef float f2_t __attribute__((ext_vector_type(2))); typedef __bf16 b2_t __attribute__((ext_vector_type(2))); f2_t v = {lo, hi}; b2_t b = __builtin_convertvector(v, b2_t); return __builtin_bit_cast(unsigned, b); }
__device__ __forceinline__ bf16x8 pack8(f32x4 a, f32x4 b) { v4u w; w.x = cvtpk(a[0], a[1]); w.y = cvtpk(a[2], a[3]); w.z = cvtpk(b[0], b[1]); w.w = cvtpk(b[2], b[3]); return __builtin_bit_cast(bf16x8, w); }

__device__ __forceinline__ float bflo(unsigned x) { return __uint_as_float(x << 16); }
__device__ __forceinline__ float bfhi(unsigned x) { return __uint_as_float(x & 0xffff0000u); }
constexpr int AT_KSTR = 208, AT_VSTR = 144, AT_KBUF = 64 * AT_KSTR, AT_VBUF = 64 * AT_VSTR;
__device__ __forceinline__ void attn_unit(Frame& F, const bf16* __restrict__ quk, const bf16* __restrict__ Kr, bf16* __restrict__ mix, int b, int h, int qb) {
    LAS unsigned char* Kb = F.lds + RING_OFF; LAS unsigned char* Vb = F.lds + RING_OFF + 2 * AT_KBUF;
    int tid_ = threadIdx.x; asm volatile("" : "+v"(tid_));
    const int tid = tid_, lane = tid & 63, w = __builtin_amdgcn_readfirstlane(tid >> 6), g = lane >> 4, c16 = lane & 15;
    const int q0 = qb * 128 + 16 * w;
    const size_t tb = (size_t)b * SEQ;
    bf16x8 qf[3];
    { const bf16* qp = quk + (tb + q0 + c16) * UP_N + h * 96 + 8 * g;
#pragma unroll
      for (int ks = 0; ks < 3; ++ks) qf[ks] = *(const bf16x8*)(qp + 32 * ks); }
    f32x4 O[4];
#pragma unroll
    for (int mt = 0; mt < 4; ++mt) O[mt] = (f32x4){0.f, 0.f, 0.f, 0.f};
    float m = -1e30f, l = 0.f;
    const int nkt = 2 * qb + 2;
    const int krow = tid >> 3, kc = tid & 7, rrow = (tid >> 2) & 63, rc = tid & 3;
    const bf16* gK = quk + (tb + krow) * UP_N + 768 + h * 128 + kc * 8;
    const bf16* gR = Kr + (tb + rrow) * 32 + rc * 8;
    v4u rk = *(const v4u*)gK, rv = *(const v4u*)(gK + 64), rr = *(const v4u*)gR;
    const int aoffK = c16 * AT_KSTR + 16 * g;
    const int aoffV = (4 * g + (c16 >> 2)) * AT_VSTR + 8 * (lane & 3);
    for (int kt = 0; kt < nkt; ++kt) {
        LAS unsigned char* Kc = Kb + (kt & 1) * AT_KBUF; LAS unsigned char* Vc = Vb + (kt & 1) * AT_VBUF;
        *(LAS v4u*)(Kc + krow * AT_KSTR + kc * 16) = rk; *(LAS v4u*)(Vc + krow * AT_VSTR + kc * 16) = rv;
        if (tid < 256) *(LAS v4u*)(Kc + rrow * AT_KSTR + 128 + rc * 16) = rr;
        __syncthreads();
        if (kt + 1 < nkt) { const size_t off = (size_t)(kt + 1) * 64; rk = *(const v4u*)(gK + off * UP_N); rv = *(const v4u*)(gK + off * UP_N + 64); rr = *(const v4u*)(gR + off * 32); }
        const int k0 = kt * 64;
        if (k0 <= q0 + 15) {
            f32x4 S[4];
#pragma unroll
            for (int mt = 0; mt < 4; ++mt) { S[mt] = (f32x4){0.f, 0.f, 0.f, 0.f};
#pragma unroll
                for (int ks = 0; ks < 3; ++ks) { const bf16x8 a = *(const LAS bf16x8*)(Kc + aoffK + mt * 16 * AT_KSTR + ks * 64); S[mt] = mfma16(a, qf[ks], S[mt]); } }
            if (k0 + 63 > q0) {
                const int q = q0 + c16;
#pragma unroll
                for (int mt = 0; mt < 4; ++mt)
#pragma unroll
                    for (int r = 0; r < 4; ++r) if (k0 + 16 * mt + 4 * g + r > q) S[mt][r] = -1e30f;
            }
            float mx = fmaxf(fmaxf(S[0][0], S[0][1]), fmaxf(S[0][2], S[0][3]));
#pragma unroll
            for (int mt = 1; mt < 4; ++mt) mx = fmaxf(mx, fmaxf(fmaxf(S[mt][0], S[mt][1]), fmaxf(S[mt][2], S[mt][3])));
            mx = fmaxf(mx, __shfl_xor(mx, 16)); mx = fmaxf(mx, __shfl_xor(mx, 32));
            const float mn = fmaxf(m, mx), alpha = __builtin_amdgcn_exp2f(m - mn); m = mn;
            float ls = 0.f;
#pragma unroll
            for (int mt = 0; mt < 4; ++mt)
#pragma unroll
                for (int r = 0; r < 4; ++r) { S[mt][r] = __builtin_amdgcn_exp2f(S[mt][r] - mn); ls += S[mt][r]; }
            l = l * alpha + ls;
#pragma unroll
            for (int mt = 0; mt < 4; ++mt) O[mt] = O[mt] * alpha;
            bf16x8 pf[2]; pf[0] = pack8(S[0], S[1]); pf[1] = pack8(S[2], S[3]);
#pragma unroll
            for (int mt = 0; mt < 4; ++mt)
#pragma unroll
                for (int s = 0; s < 2; ++s) {
                    const s16x4 v0 = lds_tr16(Vc + aoffV + (32 * s) * AT_VSTR + mt * 32), v1 = lds_tr16(Vc + aoffV + (32 * s + 16) * AT_VSTR + mt * 32);
                    O[mt] = mfma16(cat4(v0, v1), pf[s], O[mt]);
                }
        }
    }
    l += __shfl_xor(l, 16); l += __shfl_xor(l, 32);
    const float inv = 1.f / l;
    bf16* op = mix + (tb + q0 + c16) * 1024 + h * 64 + 4 * g;
#pragma unroll
    for (int mt = 0; mt < 4; ++mt) { const f32x4 o = O[mt] * inv; typedef unsigned u2_t __attribute__((ext_vector_type(2))); u2_t wv; wv.x = cvtpk(o[0], o[1]); wv.y = cvtpk(o[2], o[3]); *(u2_t*)(op + 16 * mt) = wv; }
    __syncthreads();
}
__device__ __forceinline__ void attn_phase(Frame& F, const bf16* quk, const bf16* Kr, bf16* mix) {
    for (int u = F.vcu; u < 512; u += F.G) {
        const int bh = u >> 4, p = u & 15;
        for (int j = 0; j < 2; ++j) attn_unit(F, quk, Kr, mix, bh >> 3, bh & 7, j ? p : 31 - p);
    }
}
__device__ __forceinline__ float wave_sum(float v) {
#pragma unroll
    for (int o = 1; o < 64; o <<= 1) v += __shfl_xor(v, o);
    return v;
}
__device__ __forceinline__ void p0_extras(Frame& F, const Args& a) {
    int tid_ = threadIdx.x; asm volatile("" : "+v"(tid_));
    const int tid = tid_;
    unsigned char* ws = a.ws;
    const int gt = (int)blockIdx.x * (NWAVES * 64) + tid, NT = F.G * NWAVES * 64;
    {
        const float* c = a.in[1]; const float* ada_w = a.in[3]; const float* ada_b = a.in[4]; float* mod = (float*)(ws + WS_MOD);
        for (int idx = gt; idx < DEPTH * 6 * D; idx += NT) {
            const int l = idx / (6 * D), n = idx % (6 * D);
            float acc0 = 0.f, acc1 = 0.f, acc2 = 0.f, acc3 = 0.f;
            const float* w = ada_w + (size_t)l * D * 6 * D + n;
#pragma unroll 8
            for (int k = 0; k < D; ++k) {
                const float wv = w[(size_t)k * 6 * D];
                acc0 += silu_f(c[k]) * wv; acc1 += silu_f(c[D + k]) * wv; acc2 += silu_f(c[2 * D + k]) * wv; acc3 += silu_f(c[3 * D + k]) * wv;
            }
            const float bb = ada_b[l * 6 * D + n];
            mod[((size_t)l * NB + 0) * 6 * D + n] = acc0 + bb; mod[((size_t)l * NB + 1) * 6 * D + n] = acc1 + bb;
            mod[((size_t)l * NB + 2) * 6 * D + n] = acc2 + bb; mod[((size_t)l * NB + 3) * 6 * D + n] = acc3 + bb;
        }
    }
    {
        const int* positions = (const int*)a.in[2]; float* csm = (float*)(ws + WS_CSM); float* csr = (float*)(ws + WS_CSR);
        for (int idx = gt; idx < T * 80; idx += NT) {
            const int t = idx / 80, j = idx % 80; const float pos = (float)positions[t];
            if (j < 16) { const float ang = pos * powf(10000.f, -(float)(2 * j) / 32.f); csm[((size_t)t * 16 + j) * 2] = cosf(ang); csm[((size_t)t * 16 + j) * 2 + 1] = sinf(ang); }
            else { const int i = j - 16; const float ang = pos * powf(10000.f, -(float)(2 * i) / 128.f); csr[((size_t)t * 64 + i) * 2] = cosf(ang); csr[((size_t)t * 64 + i) * 2 + 1] = sinf(ang); }
        }
    }
}
__device__ __forceinline__ void init_mod_phase(Frame& F, const float* __restrict__ x_in, float* __restrict__ x, const float* __restrict__ mod_l, bf16* __restrict__ hb) {
    int tid_ = threadIdx.x; asm volatile("" : "+v"(tid_));
    const int lane = tid_ & 63, gw = (int)blockIdx.x * NWAVES + (tid_ >> 6), NGW = F.G * NWAVES;
    for (int t = gw; t < T; t += NGW) {
        const float* m = mod_l + (size_t)(t / SEQ) * 6 * D;
#pragma unroll
        for (int j = 0; j < 4; ++j) {
            const int d = 4 * lane + 256 * j;
            const f32x4 v = *(const f32x4*)(x_in + (size_t)t * D + d), sh = *(const f32x4*)(m + d), sc = *(const f32x4*)(m + D + d);
            *(f32x4*)(x + (size_t)t * D + d) = v;
            const f32x4 hv = v * (1.f + sc) + sh;
            typedef unsigned u2_t __attribute__((ext_vector_type(2))); u2_t o; o.x = cvtpk(hv[0], hv[1]); o.y = cvtpk(hv[2], hv[3]);
            *(u2_t*)(hb + (size_t)t * D + d) = o;
        }
    }
}
__device__ __forceinline__ void mla_prep_phase(Frame& F, const bf16* __restrict__ projb, const float* __restrict__ csm, bf16* __restrict__ upA, bf16* __restrict__ Kr) {
    int tid_ = threadIdx.x; asm volatile("" : "+v"(tid_));
    const int lane = tid_ & 63, gw = (int)blockIdx.x * NWAVES + (tid_ >> 6), NGW = F.G * NWAVES;
    typedef unsigned u2_t __attribute__((ext_vector_type(2)));
    for (int t = gw; t < T; t += NGW) {
        const bf16* p = projb + (size_t)t * HY_LD;
        const u2_t qv = *(const u2_t*)(p + 4 * lane); const unsigned kv = *(const unsigned*)(p + 256 + 2 * lane);
        const float q0 = bflo(qv.x), q1 = bfhi(qv.x), q2 = bflo(qv.y), q3 = bfhi(qv.y), k0 = bflo(kv), k1 = bfhi(kv);
        const float rq = rsqrtf(wave_sum((q0 * q0 + q1 * q1) + (q2 * q2 + q3 * q3)) * (1.f / 256.f) + RMS_EPS);
        const float rk = rsqrtf(wave_sum(k0 * k0 + k1 * k1) * (1.f / 128.f) + RMS_EPS);
        u2_t o; o.x = cvtpk(q0 * rq, q1 * rq); o.y = cvtpk(q2 * rq, q3 * rq);
        *(u2_t*)(upA + (size_t)t * UP_K + 4 * lane) = o;
        *(unsigned*)(upA + (size_t)t * UP_K + 256 + 2 * lane) = cvtpk(k0 * rk, k1 * rk);
        if (lane < 16) {
            const float x1 = bf2f(p[384 + lane]), x2 = bf2f(p[400 + lane]);
            const float c = csm[((size_t)t * 16 + lane) * 2], s = csm[((size_t)t * 16 + lane) * 2 + 1];
            Kr[(size_t)t * 32 + lane] = f2b(x1 * c - x2 * s); Kr[(size_t)t * 32 + 16 + lane] = f2b(x1 * s + x2 * c);
        }
    }
}
__device__ __forceinline__ void ln_row(f32x4 (&v)[4], const float* __restrict__ g, const float* __restrict__ bta, int lane) {
    float s = 0.f;
#pragma unroll
    for (int j = 0; j < 4; ++j) s += (v[j][0] + v[j][1]) + (v[j][2] + v[j][3]);
    const float mean = wave_sum(s) * (1.f / D); float q = 0.f;
#pragma unroll
    for (int j = 0; j < 4; ++j) { v[j] = v[j] - mean; q += (v[j][0] * v[j][0] + v[j][1] * v[j][1]) + (v[j][2] * v[j][2] + v[j][3] * v[j][3]); }
    const float rstd = rsqrtf(wave_sum(q) * (1.f / D) + LN_EPS);
#pragma unroll
    for (int j = 0; j < 4; ++j) { const int d = 4 * lane + 256 * j; v[j] = v[j] * rstd * *(const f32x4*)(g + d) + *(const f32x4*)(bta + d); }
}
constexpr int LR_HSTR = 1028, LR_H = 0, LR_PART = 16 * LR_HSTR * 4, LR_LOG = LR_PART + 8 * 16 * 48 * 4, LR_CNT = LR_LOG + 16 * 48 * 4, LR_SLOT = LR_CNT + 256;
__device__ __forceinline__ void ln_router_phase(Frame& F, float* __restrict__ x, const float* __restrict__ y, const float* __restrict__ mod_l, const float* __restrict__ lg, const float* __restrict__ lb,
                                                const float* __restrict__ wgrp, const float* __restrict__ bgrp, const float* __restrict__ wexp, const float* __restrict__ bexp,
                                                bf16* __restrict__ hb, int* __restrict__ slot_e, float* __restrict__ slot_w, int* __restrict__ slot_pos, int* __restrict__ gcnt) {
    int tid_ = threadIdx.x; asm volatile("" : "+v"(tid_));
    const int tid = tid_, lane = tid & 63, w = __builtin_amdgcn_readfirstlane(tid >> 6), g = lane >> 4, c16 = lane & 15;
    LAS float* hT = (LAS float*)(F.lds + RING_OFF + LR_H); LAS float* part = (LAS float*)(F.lds + RING_OFF + LR_PART); LAS float* logit = (LAS float*)(F.lds + RING_OFF + LR_LOG);
    LAS int* lcnt = (LAS int*)(F.lds + RING_OFF + LR_CNT); LAS int* lbase = lcnt + 32; LAS int* sl_e = (LAS int*)(F.lds + RING_OFF + LR_SLOT); LAS int* sl_p = sl_e + 128; LAS float* sl_w = (LAS float*)(sl_p + 128);
    typedef unsigned u2_t __attribute__((ext_vector_type(2)));
    for (int blk = (int)blockIdx.x; blk < T / 64; blk += F.G) {
        const int r0 = blk * 64;
        if (tid < 32) lcnt[tid] = 0;
        for (int tI = 0; tI < 4; ++tI) {
#pragma unroll 1
            for (int rr = 0; rr < 2; ++rr) {
                const int lr = 2 * w + rr, t = r0 + 16 * tI + lr;
                const float* m = mod_l + (size_t)(t / SEQ) * 6 * D;
                f32x4 v[4];
#pragma unroll
                for (int j = 0; j < 4; ++j) { const int d = 4 * lane + 256 * j; v[j] = ALPHA * *(const f32x4*)(x + (size_t)t * D + d) + (1.f + *(const f32x4*)(m + 2 * D + d)) * *(const f32x4*)(y + (size_t)t * D + d); }
                ln_row(v, lg, lb, lane);
#pragma unroll
                for (int j = 0; j < 4; ++j) { const int d = 4 * lane + 256 * j;
                    *(f32x4*)(x + (size_t)t * D + d) = v[j];
                    const f32x4 hv = v[j] * (1.f + *(const f32x4*)(m + 4 * D + d)) + *(const f32x4*)(m + 3 * D + d);
                    u2_t o; o.x = cvtpk(hv[0], hv[1]); o.y = cvtpk(hv[2], hv[3]); *(u2_t*)(hb + (size_t)t * D + d) = o;
                    *(LAS f32x4*)(hT + lr * LR_HSTR + d) = hv; }
            }
            __syncthreads();
            {
                f32x4 acc[3]; acc[0] = (f32x4){0.f, 0.f, 0.f, 0.f}; acc[1] = acc[0]; acc[2] = acc[0];
#pragma unroll 2
                for (int kk = 0; kk < 8; ++kk) {
                    const int kb = 128 * w + 16 * kk + 4 * g;
                    const f32x4 a4 = *(const LAS f32x4*)(hT + c16 * LR_HSTR + kb);
#pragma unroll
                    for (int tt = 0; tt < 4; ++tt) {
                        const int k = kb + tt;
                        const float b0 = wexp[k * NE + c16], b1 = wexp[k * NE + 16 + c16], b2 = (c16 < NG) ? wgrp[k * NG + c16] : 0.f;
                        acc[0] = __builtin_amdgcn_mfma_f32_16x16x4f32(a4[tt], b0, acc[0], 0, 0, 0);
                        acc[1] = __builtin_amdgcn_mfma_f32_16x16x4f32(a4[tt], b1, acc[1], 0, 0, 0);
                        acc[2] = __builtin_amdgcn_mfma_f32_16x16x4f32(a4[tt], b2, acc[2], 0, 0, 0);
                    }
                }
#pragma unroll
                for (int nt = 0; nt < 3; ++nt)
#pragma unroll
                    for (int r = 0; r < 4; ++r) part[(w * 16 + 4 * g + r) * 48 + 16 * nt + c16] = acc[nt][r];
            }
            __syncthreads();
            for (int o = tid; o < 16 * 36; o += NWAVES * 64) {
                const int row = o / 36, col = o % 36;
                float s = 0.f;
#pragma unroll
                for (int ww = 0; ww < 8; ++ww) s += part[(ww * 16 + row) * 48 + col];
                logit[row * 48 + col] = s + (col < 32 ? bexp[col] : bgrp[col - 32]);
            }
            __syncthreads();
            if (tid < 16) {
                const LAS float* lr = logit + tid * 48;
                int gi = 0; float gbest = lr[32];
#pragma unroll
                for (int j = 1; j < 4; ++j) { const float vv = lr[32 + j]; if (vv > gbest) { gbest = vv; gi = j; } }
                float den = 0.f;
#pragma unroll
                for (int j = 0; j < 4; ++j) den += expf(lr[32 + j] - gbest);
                const float gtop = 1.f / den;
                int i0 = 0; float b0 = lr[gi * 8];
#pragma unroll
                for (int j = 1; j < 8; ++j) { const float vv = lr[gi * 8 + j]; if (vv > b0) { b0 = vv; i0 = j; } }
                int i1 = -1; float b1 = -3.4e38f;
#pragma unroll
                for (int j = 0; j < 8; ++j) { const float vv = lr[gi * 8 + j]; if (j != i0 && vv > b1) { b1 = vv; i1 = j; } }
                const float e1 = expf(b1 - b0);
                const int ex0 = gi * 8 + i0, ex1 = gi * 8 + i1, sidx = (16 * tI + tid) * 2;
                sl_e[sidx] = ex0; sl_e[sidx + 1] = ex1; sl_w[sidx] = gtop / (1.f + e1); sl_w[sidx + 1] = gtop * e1 / (1.f + e1);
                sl_p[sidx] = __hip_atomic_fetch_add(&lcnt[ex0], 1, __ATOMIC_RELAXED, __HIP_MEMORY_SCOPE_WORKGROUP); sl_p[sidx + 1] = __hip_atomic_fetch_add(&lcnt[ex1], 1, __ATOMIC_RELAXED, __HIP_MEMORY_SCOPE_WORKGROUP);
            }
            __syncthreads();
        }
        if (tid < 32) lbase[tid] = atomicAdd(&gcnt[tid], lcnt[tid]);
        __syncthreads();
        if (tid < 128) { const int gs = r0 * 2 + tid, e = sl_e[tid]; slot_e[gs] = e; slot_w[gs] = sl_w[tid]; slot_pos[gs] = lbase[e] + sl_p[tid]; }
        __syncthreads();
    }
}
__device__ __forceinline__ void gather_phase(Frame& F, const bf16* __restrict__ hb, const int* __restrict__ slot_e, const int* __restrict__ slot_pos, const int* __restrict__ gcnt,
                                             bf16* __restrict__ Xp, int* __restrict__ slot_of, int* __restrict__ tile_expert, int* __restrict__ n_tiles) {
    int tid_ = threadIdx.x; asm volatile("" : "+v"(tid_));
    const int tid = tid_, lane = tid & 63, gw = (int)blockIdx.x * NWAVES + (tid >> 6), NGW = F.G * NWAVES;
    LAS int* pstart = (LAS int*)(F.lds + RING_OFF);
    if (tid == 0) { int a = 0; for (int e = 0; e < NE; ++e) { pstart[e] = a; a += (gcnt[e] + 255) / 256 * 256; } pstart[NE] = a; }
    __syncthreads();
    if (blockIdx.x == 0) {
        if (tid == 0) *n_tiles = pstart[NE] / 256;
        for (int i = tid; i < XP_ROWS / 256; i += NWAVES * 64) { int e = 0; while (e < NE - 1 && i * 256 >= pstart[e + 1]) ++e; tile_expert[i] = e; }
    }
    for (int sl = gw; sl < 2 * T; sl += NGW) {
        const int t = sl >> 1, slot = pstart[slot_e[sl]] + slot_pos[sl];
        if (lane == 0) slot_of[sl] = slot;
        const v4u* src = (const v4u*)(hb + (size_t)t * D); v4u* dst = (v4u*)(Xp + (size_t)slot * D);
        dst[lane] = src[lane]; dst[lane + 64] = src[lane + 64];
    }
    __syncthreads();
}
__device__ __forceinline__ void ln_ffn_phase(Frame& F, float* __restrict__ x, const float* __restrict__ Yp, const int* __restrict__ slot_of, const float* __restrict__ slot_w, const float* __restrict__ mod_l,
                                             const float* __restrict__ lg, const float* __restrict__ lb, const float* __restrict__ mod_next, bf16* __restrict__ hb) {
    int tid_ = threadIdx.x; asm volatile("" : "+v"(tid_));
    const int lane = tid_ & 63, gw = (int)blockIdx.x * NWAVES + (tid_ >> 6), NGW = F.G * NWAVES;
    typedef unsigned u2_t __attribute__((ext_vector_type(2)));
    for (int t = gw; t < T; t += NGW) {
        const float* m = mod_l + (size_t)(t / SEQ) * 6 * D;
        const float w0 = slot_w[2 * t], w1 = slot_w[2 * t + 1];
        const float* y0 = Yp + (size_t)slot_of[2 * t] * D; const float* y1 = Yp + (size_t)slot_of[2 * t + 1] * D;
        f32x4 v[4];
#pragma unroll
        for (int j = 0; j < 4; ++j) { const int d = 4 * lane + 256 * j;
            const f32x4 yy = w0 * *(const f32x4*)(y0 + d) + w1 * *(const f32x4*)(y1 + d);
            v[j] = ALPHA * *(const f32x4*)(x + (size_t)t * D + d) + (1.f + *(const f32x4*)(m + 5 * D + d)) * yy; }
        ln_row(v, lg, lb, lane);
#pragma unroll
        for (int j = 0; j < 4; ++j) { const int d = 4 * lane + 256 * j;
            *(f32x4*)(x + (size_t)t * D + d) = v[j];
            if (mod_next) { const float* mn = mod_next + (size_t)(t / SEQ) * 6 * D;
                const f32x4 hv = v[j] * (1.f + *(const f32x4*)(mn + D + d)) + *(const f32x4*)(mn + d);
                u2_t o; o.x = cvtpk(hv[0], hv[1]); o.y = cvtpk(hv[2], hv[3]); *(u2_t*)(hb + (size_t)t * D + d) = o; }
        }
    }
}
constexpr int RT_STR = 272, RT_TILE = 128 * RT_STR, RT_VSTR = 80, RT_VTILE = 128 * RT_VSTR;
__device__ __forceinline__ float ret_log2gamma(int h) { return log2f(1.f - exp2f(-5.f - (float)h)); }

__device__ __forceinline__ void ret_state_phase(Frame& F, const bf16* __restrict__ projb, bf16* __restrict__ ST) {
    int tid_ = threadIdx.x; asm volatile("" : "+v"(tid_));
    const int tid = tid_, lane = tid & 63, w = __builtin_amdgcn_readfirstlane(tid >> 6), g = lane >> 4, c16 = lane & 15;
    LAS unsigned char* Kt = F.lds + RING_OFF; LAS unsigned char* Vt = F.lds + RING_OFF + 2 * RT_TILE;
    for (int u = F.vcu; u < 256; u += F.G) {
        const int bh = u >> 3, slice = u & 7, b = bh >> 3, h = bh & 7;
        const float lg = ret_log2gamma(h), cdec = exp2f(128.f * lg);
        const size_t tb = (size_t)b * SEQ;
        const int vrow = tid >> 2, vc = tid & 3;
        const bf16* gKp = projb + (tb + (tid >> 4)) * RET_IN + 1024 + h * 128 + (tid & 15) * 8;
        const bf16* gVp = projb + (tb + vrow) * RET_IN + 2048 + h * 256 + slice * 32 + vc * 8;
        const float vscale = exp2f((float)(127 - vrow) * lg);
        v4u rk[4], rv;
#pragma unroll
        for (int i = 0; i < 4; ++i) rk[i] = *(const v4u*)(gKp + (size_t)(32 * i) * RET_IN);
        rv = *(const v4u*)gVp;
        f32x4 acc[2]; acc[0] = (f32x4){0.f, 0.f, 0.f, 0.f}; acc[1] = acc[0];
        bf16* stp = ST + ((size_t)bh * 32) * 256 * 128 + (size_t)(slice * 32 + 4 * g) * 128 + 16 * w + c16;
        const int toff = (8 * g + (c16 >> 2)) * RT_STR + (16 * w + 4 * (lane & 3)) * 2;
        const int voff = (8 * g + (c16 >> 2)) * RT_VSTR + (4 * (lane & 3)) * 2;
        for (int n = 0; n < 32; ++n) {
            LAS unsigned char* Kc = Kt + (n & 1) * RT_TILE; LAS unsigned char* Vc = Vt + (n & 1) * RT_VTILE;
#pragma unroll
            for (int i = 0; i < 4; ++i) *(LAS v4u*)(Kc + ((tid >> 4) + 32 * i) * RT_STR + (tid & 15) * 16) = rk[i];
            { v4u o;
#pragma unroll
              for (int j = 0; j < 4; ++j) { const unsigned x = rv[j]; o[j] = cvtpk(__uint_as_float(x << 16) * vscale, __uint_as_float(x & 0xffff0000u) * vscale); }
              *(LAS v4u*)(Vc + vrow * RT_VSTR + vc * 16) = o; }
            __syncthreads();
            if (n + 1 < 32) {
#pragma unroll
                for (int i = 0; i < 4; ++i) rk[i] = *(const v4u*)(gKp + (size_t)((n + 1) * 128 + 32 * i) * RET_IN);
                rv = *(const v4u*)(gVp + (size_t)((n + 1) * 128) * RET_IN);
            }
            { bf16* sp = stp + (size_t)n * 256 * 128;
#pragma unroll
              for (int mt = 0; mt < 2; ++mt)
#pragma unroll
                  for (int r = 0; r < 4; ++r) sp[(16 * mt + r) * 128] = (bf16)(cvtpk(acc[mt][r], 0.f) & 0xffffu); }
            acc[0] = acc[0] * cdec; acc[1] = acc[1] * cdec;
#pragma unroll
            for (int ks = 0; ks < 4; ++ks) {
                const bf16x8 bk = cat4(lds_tr16(Kc + toff + (32 * ks) * RT_STR), lds_tr16(Kc + toff + (32 * ks + 4) * RT_STR));
#pragma unroll
                for (int mt = 0; mt < 2; ++mt) {
                    const bf16x8 av = cat4(lds_tr16(Vc + voff + (32 * ks) * RT_VSTR + mt * 32), lds_tr16(Vc + voff + (32 * ks + 4) * RT_VSTR + mt * 32));
                    acc[mt] = mfma16(av, bk, acc[mt]);
                }
            }
        }
        __syncthreads();
    }
}

__device__ __forceinline__ void ret_chunk_phase(Frame& F, const bf16* __restrict__ projb, const bf16* __restrict__ ST, const float* __restrict__ gn_g, const float* __restrict__ gn_b, bf16* __restrict__ mix) {
    int tid_ = threadIdx.x; asm volatile("" : "+v"(tid_));
    const int tid = tid_, lane = tid & 63, w = __builtin_amdgcn_readfirstlane(tid >> 6), g = lane >> 4, c16 = lane & 15;
    LAS unsigned char* Kt = F.lds + RING_OFF; LAS unsigned char* Vt = Kt + RT_TILE; LAS unsigned char* St = Vt + RT_TILE;
    const int srow = tid >> 4, sc = tid & 15;
    for (int u = F.vcu; u < 1024; u += F.G) {
        const int bh = u >> 5, n = u & 31, b = bh >> 3, h = bh & 7;
        const float lg = ret_log2gamma(h);
        const size_t t0 = (size_t)b * SEQ + (size_t)n * 128;
        const bf16* gK = projb + (t0 + srow) * RET_IN + 1024 + h * 128 + sc * 8;
        const bf16* gV = projb + (t0 + srow) * RET_IN + 2048 + h * 256 + sc * 8;
        const bf16* gS = ST + ((size_t)bh * 32 + n) * 256 * 128 + (size_t)srow * 128 + sc * 8;
        v4u rk[4], rv[4], rs[4];
#pragma unroll
        for (int i = 0; i < 4; ++i) { rk[i] = *(const v4u*)(gK + (size_t)(32 * i) * RET_IN); rv[i] = *(const v4u*)(gV + (size_t)(32 * i) * RET_IN); rs[i] = *(const v4u*)(gS + (size_t)(32 * i) * 128); }
        bf16x8 qf[4];
        { const bf16* qp = projb + (t0 + 16 * w + c16) * RET_IN + h * 128 + 8 * g;
#pragma unroll
          for (int ks = 0; ks < 4; ++ks) qf[ks] = *(const bf16x8*)(qp + 32 * ks); }
#pragma unroll
        for (int i = 0; i < 4; ++i) { const int o = (srow + 32 * i) * RT_STR + sc * 16; *(LAS v4u*)(Kt + o) = rk[i]; *(LAS v4u*)(Vt + o) = rv[i]; *(LAS v4u*)(St + o) = rs[i]; }
        __syncthreads();
#pragma unroll
        for (int i = 0; i < 4; ++i) { rv[i] = *(const v4u*)(gV + (size_t)(32 * i) * RET_IN + 128); rs[i] = *(const v4u*)(gS + (size_t)(32 * i) * 128 + 128 * 128); }
        const int irow = 16 * w + c16;
        bf16x8 pf[4];
        {
            const int koff = c16 * RT_STR + 16 * g;
            f32x4 P[8];
#pragma unroll
            for (int mt = 0; mt < 8; ++mt) {
                P[mt] = (f32x4){0.f, 0.f, 0.f, 0.f};
                if (mt <= w) {
#pragma unroll
                    for (int ks = 0; ks < 4; ++ks) P[mt] = mfma16(*(const LAS bf16x8*)(Kt + koff + mt * 16 * RT_STR + ks * 64), qf[ks], P[mt]);
#pragma unroll
                    for (int r = 0; r < 4; ++r) { const int j = 16 * mt + 4 * g + r; P[mt][r] = (j <= irow) ? P[mt][r] * __builtin_amdgcn_exp2f((float)(irow - j) * lg) : 0.f; }
                }
            }
#pragma unroll
            for (int s = 0; s < 4; ++s) pf[s] = pack8(P[2 * s], P[2 * s + 1]);
        }
        const float cdi = __builtin_amdgcn_exp2f((float)(irow + 1) * lg);
        f32x4 acc[2][8];
        const int soff = c16 * RT_STR + 16 * g;
        const int voff = (4 * g + (c16 >> 2)) * RT_STR + 8 * (lane & 3);
#pragma unroll
        for (int hf = 0; hf < 2; ++hf) {
            if (hf == 1) {
                __syncthreads();
#pragma unroll
                for (int i = 0; i < 4; ++i) { const int o = (srow + 32 * i) * RT_STR + sc * 16; *(LAS v4u*)(Vt + o) = rv[i]; *(LAS v4u*)(St + o) = rs[i]; }
                __syncthreads();
            }
#pragma unroll
            for (int mt = 0; mt < 8; ++mt) {
                f32x4 a = (f32x4){0.f, 0.f, 0.f, 0.f};
#pragma unroll
                for (int ks = 0; ks < 4; ++ks) a = mfma16(*(const LAS bf16x8*)(St + soff + mt * 16 * RT_STR + ks * 64), qf[ks], a);
                acc[hf][mt] = a * cdi;
            }
#pragma unroll
            for (int s = 0; s < 4; ++s) {
                if (2 * s <= w) {
#pragma unroll
                    for (int mt = 0; mt < 8; ++mt)
                        acc[hf][mt] = mfma16(cat4(lds_tr16(Vt + voff + (32 * s) * RT_STR + mt * 32), lds_tr16(Vt + voff + (32 * s + 16) * RT_STR + mt * 32)), pf[s], acc[hf][mt]);
                }
            }
        }
        float s1 = 0.f;
#pragma unroll
        for (int hf = 0; hf < 2; ++hf)
#pragma unroll
            for (int mt = 0; mt < 8; ++mt) s1 += (acc[hf][mt][0] + acc[hf][mt][1]) + (acc[hf][mt][2] + acc[hf][mt][3]);
        s1 += __shfl_xor(s1, 16); s1 += __shfl_xor(s1, 32);
        const float mean = s1 * (1.f / 256.f);
        float s2 = 0.f;
#pragma unroll
        for (int hf = 0; hf < 2; ++hf)
#pragma unroll
            for (int mt = 0; mt < 8; ++mt) { const f32x4 d = acc[hf][mt] - mean; s2 += (d[0] * d[0] + d[1] * d[1]) + (d[2] * d[2] + d[3] * d[3]); }
        s2 += __shfl_xor(s2, 16); s2 += __shfl_xor(s2, 32);
        const float rstd = rsqrtf(s2 * (1.f / 256.f) + LN_EPS);
        const size_t trow = t0 + irow;
#pragma unroll
        for (int hf = 0; hf < 2; ++hf)
#pragma unroll
            for (int mt = 0; mt < 8; ++mt) {
                const int c = h * 256 + hf * 128 + 16 * mt + 4 * g;
                typedef unsigned u2_t __attribute__((ext_vector_type(2)));
                const u2_t gw = *(const u2_t*)(projb + trow * RET_IN + 4096 + c);
                const f32x4 gg = *(const f32x4*)(gn_g + c), gb = *(const f32x4*)(gn_b + c);
                const float g0 = __uint_as_float(gw.x << 16), g1 = __uint_as_float(gw.x & 0xffff0000u), g2 = __uint_as_float(gw.y << 16), g3 = __uint_as_float(gw.y & 0xffff0000u);
                const f32x4 o = (acc[hf][mt] - mean) * rstd * gg + gb;
                u2_t ov; ov.x = cvtpk(silu_f(g0) * o[0], silu_f(g1) * o[1]); ov.y = cvtpk(silu_f(g2) * o[2], silu_f(g3) * o[3]);
                *(u2_t*)(mix + trow * RET_MIX + c) = ov;
            }
        __syncthreads();
    }
}
constexpr int GD_STR = 144, GD_TILE = 64 * GD_STR, GD_WAVE_LDS = 3 * GD_TILE + 512;
constexpr int GD_UNIT_ELEMS = 5 * 4096;

__device__ __forceinline__ void gdn_conv64(const bf16* __restrict__ prow, int cb, const float* __restrict__ cw, int nvalid  , float (&out)[64]) {
    float mk[4]; ptrdiff_t ro[4];
#pragma unroll
    for (int k = 0; k < 4; ++k) { const bool ok = (k >= 4 - nvalid); mk[k] = ok ? 1.f : 0.f; ro[k] = ok ? (ptrdiff_t)(k - 3) * HY_LD : 0; }
#pragma unroll
    for (int cc = 0; cc < 8; ++cc) {
        float acc[8];
#pragma unroll
        for (int e = 0; e < 8; ++e) acc[e] = 0.f;
#pragma unroll
        for (int k = 0; k < 4; ++k) {
            const v4u x = *(const v4u*)(prow + ro[k] + cb + cc * 8);
            const float* wk = cw + k * 1536 + cb + cc * 8;
#pragma unroll
            for (int e2 = 0; e2 < 4; ++e2) { acc[2 * e2] += (wk[2 * e2] * mk[k]) * bflo(x[e2]); acc[2 * e2 + 1] += (wk[2 * e2 + 1] * mk[k]) * bfhi(x[e2]); }
        }
#pragma unroll
        for (int e = 0; e < 8; ++e) out[cc * 8 + e] = silu_f(acc[e]);
        asm volatile("" ::: "memory"); __builtin_amdgcn_sched_barrier(0);
    }
}
__device__ __forceinline__ void lds_put_row(LAS unsigned char* rowp, const float (&v)[64], float sc) {
#pragma unroll
    for (int cc = 0; cc < 8; ++cc) { v4u o;
#pragma unroll
        for (int e2 = 0; e2 < 4; ++e2) o[e2] = cvtpk(v[cc * 8 + 2 * e2] * sc, v[cc * 8 + 2 * e2 + 1] * sc);
        *(LAS v4u*)(rowp + cc * 16) = o; }
}
template <int I> __device__ __forceinline__ void fs_row(float (&Tc)[64], const LAS unsigned char* T0, int lane) {
    constexpr int NC = (I + 7) / 8;
    float acc = (I == lane) ? 1.f : 0.f;
    if constexpr (NC > 0) {
        v4u rw[NC];
#pragma unroll
        for (int jc = 0; jc < NC; ++jc) rw[jc] = *(const LAS v4u*)(T0 + I * GD_STR + jc * 16);
#pragma unroll
        for (int jc = 0; jc < NC; ++jc)
#pragma unroll
            for (int e2 = 0; e2 < 4; ++e2) {
                if (jc * 8 + 2 * e2 < I) acc -= bflo(rw[jc][e2]) * Tc[jc * 8 + 2 * e2];
                if (jc * 8 + 2 * e2 + 1 < I) acc -= bfhi(rw[jc][e2]) * Tc[jc * 8 + 2 * e2 + 1];
            }
    }
    Tc[I] = acc;
    __builtin_amdgcn_sched_barrier(0);
}
template <int I0, int I1> struct FsRange {
    static __device__ __forceinline__ void run(float (&Tc)[64], const LAS unsigned char* T0, int lane) {
        if constexpr (I1 - I0 == 1) fs_row<I0>(Tc, T0, lane);
        else { FsRange<I0, (I0 + I1) / 2>::run(Tc, T0, lane); FsRange<(I0 + I1) / 2, I1>::run(Tc, T0, lane); }
    }
};
__device__ __forceinline__ void gdn_prep_unit(const bf16* __restrict__ projb, const float* __restrict__ conv_w, const float* __restrict__ a_log, const float* __restrict__ dt_bias,
                                              bf16* __restrict__ GD, float* __restrict__ GL, int unit, int lane_in, LAS unsigned char* lw) {
    int lane = lane_in; asm volatile("" : "+v"(lane));
    const int bh = unit >> 6, n = unit & 63, b = bh >> 3, h = bh & 7, g = lane >> 4, c16 = lane & 15;
    const size_t t0 = (size_t)b * SEQ + (size_t)n * 64;
    LAS unsigned char* T0 = lw; LAS unsigned char* Kt = lw + GD_TILE; LAS unsigned char* Vt = lw + 2 * GD_TILE;
    LAS float* gbuf = (LAS float*)(lw + 3 * GD_TILE); LAS float* bbuf = gbuf + 64;
    bf16* gd = GD + (size_t)unit * GD_UNIT_ELEMS;
    const bf16* prow = projb + (t0 + lane) * HY_LD + MLA_COLS;
    const int spos = n * 64 + lane; const int nvalid = spos >= 3 ? 4 : spos + 1;
    const float av = bf2f(prow[1536 + h]), bv = bf2f(prow[1544 + h]);
    const float beta = 1.f / (1.f + expf(-bv));
    const float z = av + dt_bias[h];
    const float la = -expf(a_log[h]) * ((z > 20.f) ? z : log1pf(expf(z)));
    float gs = la;
#pragma unroll
    for (int o = 1; o < 64; o <<= 1) { const float t = __shfl_up(gs, o); if (lane >= o) gs += t; }
    const float glast = __shfl(gs, 63);
    const float eg = expf(gs);
    gbuf[lane] = gs; bbuf[lane] = beta;
    if (lane == 0) GL[unit] = expf(glast);
    {
        float r[64];
        gdn_conv64(prow, h * 64, conv_w, nvalid, r);
        float ss = 0.f;
#pragma unroll
        for (int e = 0; e < 64; ++e) ss += r[e] * r[e];
        const float rn = rsqrtf(ss + RMS_EPS) * 0.125f;
        lds_put_row(T0 + lane * GD_STR, r, rn);
        { const float sc = rn * eg; bf16* qg = gd + 3 * 4096 + lane * 64;
#pragma unroll
          for (int cc = 0; cc < 8; ++cc) { v4u o;
#pragma unroll
              for (int e2 = 0; e2 < 4; ++e2) o[e2] = cvtpk(r[cc * 8 + 2 * e2] * sc, r[cc * 8 + 2 * e2 + 1] * sc);
              *(v4u*)(qg + cc * 8) = o; } }
        gdn_conv64(prow, 512 + h * 64, conv_w, nvalid, r);
        ss = 0.f;
#pragma unroll
        for (int e = 0; e < 64; ++e) ss += r[e] * r[e];
        const float rk = rsqrtf(ss + RMS_EPS);
        lds_put_row(Kt + lane * GD_STR, r, rk);
        { const float sc = rk * expf(glast - gs); bf16* kd = gd + 4 * 4096 + lane;
#pragma unroll
          for (int e = 0; e < 64; ++e) kd[e * 64] = (bf16)(cvtpk(r[e] * sc, 0.f) & 0xffffu); }
        gdn_conv64(prow, 1024 + h * 64, conv_w, nvalid, r);
        lds_put_row(Vt + lane * GD_STR, r, 1.f);
    }
    asm volatile("s_waitcnt lgkmcnt(0)" ::: "memory"); __builtin_amdgcn_sched_barrier(0);
    {
        bf16* ai = gd;
#pragma unroll
        for (int m = 0; m < 4; ++m) {
            f32x4 qk[4], kk[4];
#pragma unroll
            for (int nn = 0; nn <= m; ++nn) {
                qk[nn] = (f32x4){0.f, 0.f, 0.f, 0.f}; kk[nn] = qk[nn];
#pragma unroll
                for (int ks = 0; ks < 2; ++ks) {
                    const bf16x8 aq = *(const LAS bf16x8*)(T0 + (16 * m + c16) * GD_STR + (32 * ks + 8 * g) * 2);
                    const bf16x8 ak = *(const LAS bf16x8*)(Kt + (16 * m + c16) * GD_STR + (32 * ks + 8 * g) * 2);
                    const bf16x8 bk = *(const LAS bf16x8*)(Kt + (16 * nn + c16) * GD_STR + (32 * ks + 8 * g) * 2);
                    qk[nn] = mfma16(aq, bk, qk[nn]); kk[nn] = mfma16(ak, bk, kk[nn]);
                }
            }
            asm volatile("s_waitcnt lgkmcnt(0)" ::: "memory"); __builtin_amdgcn_sched_barrier(0);
#pragma unroll
            for (int nn = 0; nn < 4; ++nn) {
                if (nn <= m) {
                    const int j = 16 * nn + c16; const float gj = gbuf[j];
#pragma unroll
                    for (int r = 0; r < 4; ++r) {
                        const int i = 16 * m + 4 * g + r; const float gi = gbuf[i], bi = bbuf[i];
                        const float dec = (i >= j) ? expf(gi - gj) : 0.f;
                        ai[i * 64 + j] = (bf16)(cvtpk(qk[nn][r] * dec, 0.f) & 0xffffu);
                        const float lv = (i > j) ? kk[nn][r] * bi * dec : 0.f;
                        *(LAS bf16*)(T0 + i * GD_STR + j * 2) = (bf16)(cvtpk(lv, 0.f) & 0xffffu);
                    }
                } else {
#pragma unroll
                    for (int r = 0; r < 4; ++r) ai[(16 * m + 4 * g + r) * 64 + 16 * nn + c16] = (bf16)0;
                }
            }
            asm volatile("s_waitcnt lgkmcnt(0)" ::: "memory"); __builtin_amdgcn_sched_barrier(0);
        }
    }
    asm volatile("s_waitcnt lgkmcnt(0)" ::: "memory"); __builtin_amdgcn_sched_barrier(0);
    float Tc[64];
    FsRange<0, 64>::run(Tc, T0, lane);
    asm volatile("s_waitcnt lgkmcnt(0)" ::: "memory"); __builtin_amdgcn_sched_barrier(0);
#pragma unroll
    for (int pass = 0; pass < 2; ++pass) {
        const float sc = pass ? beta * eg : beta;
#pragma unroll
        for (int i = 0; i < 64; ++i) *(LAS bf16*)(T0 + i * GD_STR + lane * 2) = (bf16)(cvtpk(Tc[i] * sc, 0.f) & 0xffffu);
        asm volatile("s_waitcnt lgkmcnt(0)" ::: "memory");
        const LAS unsigned char* Bt = pass ? Kt : Vt;
        bf16* outp = gd + (pass ? 2 : 1) * 4096;
#pragma unroll
        for (int m = 0; m < 4; ++m)
#pragma unroll
            for (int nn = 0; nn < 4; ++nn) {
                f32x4 acc = (f32x4){0.f, 0.f, 0.f, 0.f};
#pragma unroll
                for (int ks = 0; ks < 2; ++ks) {
                    const bf16x8 a = *(const LAS bf16x8*)(T0 + (16 * m + c16) * GD_STR + (32 * ks + 8 * g) * 2);
                    const int ro = (32 * ks + 8 * g + (c16 >> 2)) * GD_STR + (16 * nn + 4 * (lane & 3)) * 2;
                    acc = mfma16(a, cat4(lds_tr16(Bt + ro), lds_tr16(Bt + ro + 4 * GD_STR)), acc);
                }
#pragma unroll
                for (int r = 0; r < 4; ++r) outp[(16 * m + 4 * g + r) * 64 + 16 * nn + c16] = (bf16)(cvtpk(acc[r], 0.f) & 0xffffu);
                __builtin_amdgcn_sched_barrier(0);
            }
        asm volatile("s_waitcnt lgkmcnt(0)" ::: "memory");
    }
}
__device__ __forceinline__ void gdn_prep_phase(Frame& F, const bf16* projb, const float* conv_w, const float* a_log, const float* dt_bias, bf16* GD, float* GL) {
    int tid_ = threadIdx.x; asm volatile("" : "+v"(tid_));
    const int tid = tid_, lane = tid & 63, w = __builtin_amdgcn_readfirstlane(tid >> 6);
    if (w < 4) {
        LAS unsigned char* lw = F.lds + RING_OFF + w * GD_WAVE_LDS;
        for (int u = F.vcu * 4 + w; u < 2048; u += F.G * 4) gdn_prep_unit(projb, conv_w, a_log, dt_bias, GD, GL, u, lane, lw);
    }
    __syncthreads();
}

constexpr int GS_BUF = 5 * GD_TILE, GS_OSTR = 272, GS_OBUF = 64 * GS_OSTR;
__device__ __forceinline__ bf16x8 ld_perm(const LAS unsigned char* p) {
    return cat4(*(const LAS s16x4*)p, *(const LAS s16x4*)(p + 32));
}
__device__ __forceinline__ void gdn_scan_unit(Frame& F, const bf16* __restrict__ GD, const float* __restrict__ GL, const bf16* __restrict__ projb, const float* __restrict__ o_norm, bf16* __restrict__ mix, int bh) {
    int tid_ = threadIdx.x; asm volatile("" : "+v"(tid_));
    const int tid = tid_, lane = tid & 63, w = __builtin_amdgcn_readfirstlane(tid >> 6), g = lane >> 4, c16 = lane & 15;
    LAS unsigned char* Bf = F.lds + RING_OFF; LAS unsigned char* Ob = F.lds + RING_OFF + 2 * GS_BUF;
    const int b = bh >> 3, h = bh & 7;
    const bf16* gsrc = GD + (size_t)bh * 64 * GD_UNIT_ELEMS + (size_t)(tid >> 3) * 64 + (tid & 7) * 8;
    const int ldst = (tid >> 3) * GD_STR + (tid & 7) * 16;
    v4u rg[5];
#pragma unroll
    for (int i = 0; i < 5; ++i) rg[i] = *(const v4u*)(gsrc + i * 4096);
    f32x4 S[4];
#pragma unroll
    for (int m = 0; m < 4; ++m) S[m] = (f32x4){0.f, 0.f, 0.f, 0.f};
    const int aoff = c16 * GD_STR + 8 * g;
    for (int n = 0; n <= 64; ++n) {
        if (n < 64) {
            LAS unsigned char* Bc = Bf + (n & 1) * GS_BUF;
#pragma unroll
            for (int i = 0; i < 5; ++i) *(LAS v4u*)(Bc + i * GD_TILE + ldst) = rg[i];
        }
        __syncthreads();
        if (n + 1 < 64) {
#pragma unroll
            for (int i = 0; i < 5; ++i) rg[i] = *(const v4u*)(gsrc + (size_t)(n + 1) * GD_UNIT_ELEMS + i * 4096);
        }
        if (w < 4) {
            if (n < 64) {
                const LAS unsigned char* Bc = Bf + (n & 1) * GS_BUF;
                const LAS unsigned char* Ai = Bc; const LAS unsigned char* Ut = Bc + GD_TILE; const LAS unsigned char* Wt = Bc + 2 * GD_TILE;
                const LAS unsigned char* Qg = Bc + 3 * GD_TILE; const LAS unsigned char* Kd = Bc + 4 * GD_TILE;
                const float egl = GL[bh * 64 + n];
                bf16x8 sb[2]; sb[0] = pack8(S[0], S[1]); sb[1] = pack8(S[2], S[3]);
                f32x4 vn[4], o[4];
#pragma unroll
                for (int m = 0; m < 4; ++m) {
                    f32x4 a = (f32x4){0.f, 0.f, 0.f, 0.f}; f32x4 oq = a;
#pragma unroll
                    for (int s = 0; s < 2; ++s) { a = mfma16(ld_perm(Wt + aoff + m * 16 * GD_STR + s * 64), sb[s], a); oq = mfma16(ld_perm(Qg + aoff + m * 16 * GD_STR + s * 64), sb[s], oq); }
#pragma unroll
                    for (int r = 0; r < 4; ++r) vn[m][r] = bf2f(*(const LAS bf16*)(Ut + (16 * m + 4 * g + r) * GD_STR + (16 * w + c16) * 2)) - a[r];
                    o[m] = oq;
                }
                bf16x8 vb[2]; vb[0] = pack8(vn[0], vn[1]); vb[1] = pack8(vn[2], vn[3]);
#pragma unroll
                for (int m = 0; m < 4; ++m) {
                    S[m] = S[m] * egl;
#pragma unroll
                    for (int s = 0; s < 2; ++s) { o[m] = mfma16(ld_perm(Ai + aoff + m * 16 * GD_STR + s * 64), vb[s], o[m]); S[m] = mfma16(ld_perm(Kd + aoff + m * 16 * GD_STR + s * 64), vb[s], S[m]); }
                }
                LAS unsigned char* Oc = Ob + (n & 1) * GS_OBUF;
#pragma unroll
                for (int m = 0; m < 4; ++m)
#pragma unroll
                    for (int r = 0; r < 4; ++r) *(LAS float*)(Oc + (16 * m + 4 * g + r) * GS_OSTR + (16 * w + c16) * 4) = o[m][r];
            }
        } else if (n > 0) {
            const LAS unsigned char* Oc = Ob + ((n - 1) & 1) * GS_OBUF;
            const int row = (tid - 256) >> 2, q4 = tid & 3;
            f32x4 v[4]; float ss = 0.f;
#pragma unroll
            for (int i = 0; i < 4; ++i) { v[i] = *(const LAS f32x4*)(Oc + row * GS_OSTR + (16 * q4 + 4 * i) * 4); ss += (v[i][0] * v[i][0] + v[i][1] * v[i][1]) + (v[i][2] * v[i][2] + v[i][3] * v[i][3]); }
            ss += __shfl_xor(ss, 1); ss += __shfl_xor(ss, 2);
            const float rn = rsqrtf(ss * (1.f / 64.f) + RMS_EPS);
            const size_t t = (size_t)b * SEQ + (size_t)(n - 1) * 64 + row;
            const bf16* gp = projb + t * HY_LD + MLA_COLS + 1552 + h * 64 + 16 * q4;
            const v4u g0 = *(const v4u*)gp, g1 = *(const v4u*)(gp + 8);
            const float* on = o_norm + 16 * q4;
            v4u o0, o1;
#pragma unroll
            for (int e2 = 0; e2 < 4; ++e2) {
                const int i0 = 2 * e2, i1 = 2 * e2 + 1;
                o0[e2] = cvtpk(v[i0 >> 2][i0 & 3] * rn * on[i0] * silu_f(bflo(g0[e2])), v[i1 >> 2][i1 & 3] * rn * on[i1] * silu_f(bfhi(g0[e2])));
                o1[e2] = cvtpk(v[2 + (i0 >> 2)][i0 & 3] * rn * on[8 + i0] * silu_f(bflo(g1[e2])), v[2 + (i1 >> 2)][i1 & 3] * rn * on[8 + i1] * silu_f(bfhi(g1[e2])));
            }
            bf16* mp = mix + t * 1024 + 512 + h * 64 + 16 * q4;
            *(v4u*)mp = o0; *(v4u*)(mp + 8) = o1;
        }
    }
    __syncthreads();
}
__device__ __forceinline__ void attn_gdn_phase(Frame& F, const bf16* quk, const bf16* Kr, bf16* mix, const bf16* GD, const float* GL, const bf16* projb, const float* o_norm, gu32* qctr) {
    if (F.vcu < 32) gdn_scan_unit(F, GD, GL, projb, o_norm, mix, F.vcu);
    for (;;) {
        if (threadIdx.x == 0) F.MISC[16] = __hip_atomic_fetch_add(qctr, 1u, RLX_AGENT);
        __syncthreads();
        const unsigned k = F.MISC[16];
        __syncthreads();
        if (k >= 1024u) break;
        const int qb = 31 - (int)(k >> 5), bh = (int)(k & 31u);
        attn_unit(F, quk, Kr, mix, bh >> 3, bh & 7, qb);
    }
}
__global__ void __launch_bounds__(NWAVES * 64, 2) mega(Args args) {
    extern __shared__ __attribute__((aligned(16))) unsigned char lds[];
    Frame F;
    F.lds = (LAS unsigned char*)lds; F.MISC = (volatile LAS unsigned*)(F.lds + MISC_OFF);
    F.tid = threadIdx.x; F.lane = F.tid & 63; F.wave = __builtin_amdgcn_readfirstlane(F.tid >> 6);
    F.G = gridDim.x; { const int bx = blockIdx.x; F.vcu = (F.G % 8 == 0) ? (bx % 8) * (F.G / 8) + bx / 8 : bx; }
    F.ctl = (gu32*)(args.ws + WS_CTL);
    for (int u = F.tid; u < (LDS_BYTES - LDSCTL_OFF) / 4; u += NWAVES * 64) ((LAS unsigned*)(F.lds + LDSCTL_OFF))[u] = 0u;
    __syncthreads();
    const int lo = args.ph_lo, hi = args.ph_hi;
#define IN(k) (lo <= (k) && (k) < hi)
    XcdBarrier bar = xcd_barrier_post((unsigned*)(F.ctl + CW_BAR) + args.li * XCD_BAR_WORDS, F.MISC + 8);
#define SEAM2(a, b) do { if (IN(a) && IN(b)) xcd_barrier(bar); } while (0)
#define SEAM(k) SEAM2(k, (k) + 1)
#define WSP(name) unsigned char* name = args.ws; asm volatile("" : "+s"(name))
#define GEMM_PHASE(EPI, SCHED, g, S, E) pg8::gemm_phase<EPI, SCHED, PG8_ALIGN, PG8_SP2>(F.lds + RING_OFF, g, S, E)
#define MODL(ws, l) ((const float*)(ws + WS_MOD) + (size_t)(l) * NB * 6 * D)
    if (IN(0)) { p0_extras(F, args); p0_weights(F, args); }
    SEAM(0);
    if (IN(1)) { WSP(ws); init_mod_phase(F, args.in[0], args.out, MODL(ws, 0), (bf16*)(ws + WS_HB)); }
    SEAM(1);
    for (int l = 0; l < DEPTH; ++l) {
        const int pb = 2 + l * 16;
        if ((l & 1) == 0) {
            if (IN(pb + 0)) { WSP(ws); const int i = l >> 1; pg8::Gemm g{(const bf16*)(ws + WS_HB), (const bf16*)(ws + WS_WIN) + (size_t)i * HY_LD * D, T, HY_LD, D}; pg8::StaticOrder S; S.init(T, HY_LD, F.G, (int)blockIdx.x);
                pg8::EpiB16 E{(bf16*)(ws + WS_R1), HY_LD, -1}; GEMM_PHASE(pg8::EpiB16, pg8::StaticOrder, g, S, E); }
            SEAM(pb + 0);
            if (IN(pb + 1)) { WSP(ws); const int i = l >> 1; mla_prep_phase(F, (const bf16*)(ws + WS_R1), (const float*)(ws + WS_CSM), (bf16*)(ws + WS_UPA), (bf16*)(ws + WS_KR));
                gdn_prep_phase(F, (const bf16*)(ws + WS_R1), args.in[14] + (size_t)i * 4 * 1536, args.in[15] + i * 8, args.in[16] + i * 8, (bf16*)(ws + WS_GD), (float*)(ws + WS_GL)); }
            SEAM(pb + 1);
            if (IN(pb + 2)) { WSP(ws); const int i = l >> 1; pg8::Gemm g{(const bf16*)(ws + WS_UPA), (const bf16*)(ws + WS_WUP) + (size_t)i * UP_N * UP_K, T, UP_N, UP_K}; pg8::StaticOrder S; S.init(T, UP_N, F.G, (int)blockIdx.x);
                pg8::EpiQuk E{(bf16*)(ws + WS_QUK), UP_N, (const float*)(ws + WS_CSM)}; GEMM_PHASE(pg8::EpiQuk, pg8::StaticOrder, g, S, E); }
            SEAM(pb + 2);
            if (IN(pb + 3)) { WSP(ws); const int i = l >> 1; attn_gdn_phase(F, (const bf16*)(ws + WS_QUK), (const bf16*)(ws + WS_KR), (bf16*)(ws + WS_R2), (const bf16*)(ws + WS_GD), (const float*)(ws + WS_GL),
                                                                   (const bf16*)(ws + WS_R1), args.in[17] + i * 64, (gu32*)(ws + WS_CTL) + CW_AQ + 64 * l); }
            SEAM(pb + 3);
            if (IN(pb + 4)) { WSP(ws); const int i = l >> 1; pg8::Gemm g{(const bf16*)(ws + WS_R2), (const bf16*)(ws + WS_WOUT) + (size_t)i * D * D, T, D, D}; pg8::StaticOrder S; S.init(T, D, F.G, (int)blockIdx.x);
                pg8::EpiF32 E{(float*)(ws + WS_Y), D, -1}; GEMM_PHASE(pg8::EpiF32, pg8::StaticOrder, g, S, E); }
        } else {
            if (IN(pb + 0)) { WSP(ws); const int i = l >> 1; pg8::Gemm g{(const bf16*)(ws + WS_HB), (const bf16*)(ws + WS_RIN) + (size_t)i * RET_IN * D, T, RET_IN, D}; pg8::StaticOrder S; S.init(T, RET_IN, F.G, (int)blockIdx.x);
                pg8::EpiRet E{(bf16*)(ws + WS_R1), RET_IN, (const float*)(ws + WS_CSR)}; GEMM_PHASE(pg8::EpiRet, pg8::StaticOrder, g, S, E); }
            SEAM(pb + 0);
            if (IN(pb + 1)) { WSP(ws); ret_state_phase(F, (const bf16*)(ws + WS_R1), (bf16*)(ws + WS_ST)); }
            SEAM2(pb + 1, pb + 3);
            if (IN(pb + 3)) { WSP(ws); const int i = l >> 1; ret_chunk_phase(F, (const bf16*)(ws + WS_R1), (const bf16*)(ws + WS_ST), args.in[20] + (size_t)i * RET_MIX, args.in[21] + (size_t)i * RET_MIX, (bf16*)(ws + WS_R2)); }
            SEAM(pb + 3);
            if (IN(pb + 4)) { WSP(ws); const int i = l >> 1; pg8::Gemm g{(const bf16*)(ws + WS_R2), (const bf16*)(ws + WS_ROUT) + (size_t)i * D * RET_MIX, T, D, RET_MIX}; pg8::StaticOrder S; S.init(T, D, F.G, (int)blockIdx.x);
                pg8::EpiF32 E{(float*)(ws + WS_Y), D, -1}; GEMM_PHASE(pg8::EpiF32, pg8::StaticOrder, g, S, E); }
        }
        SEAM(pb + 4);
        if (IN(pb + 5)) { WSP(ws); ln_router_phase(F, args.out, (const float*)(ws + WS_Y), MODL(ws, l), args.in[5] + l * D, args.in[6] + l * D,
                                                     args.in[23] + (size_t)l * D * NG, args.in[24] + l * NG, args.in[25] + (size_t)l * D * NE, args.in[26] + l * NE,
                                                     (bf16*)(ws + WS_HB), (int*)(ws + WS_TAB_SE), (float*)(ws + WS_TAB_SW), (int*)(ws + WS_TAB_SP), (int*)(ws + WS_CTL) + CW_CNT + 64 * l); }
        SEAM(pb + 5);
        if (IN(pb + 6)) { WSP(ws); gather_phase(F, (const bf16*)(ws + WS_HB), (const int*)(ws + WS_TAB_SE), (const int*)(ws + WS_TAB_SP), (const int*)(ws + WS_CTL) + CW_CNT + 64 * l,
                                                  (bf16*)(ws + WS_R1), (int*)(ws + WS_TAB_SO), (int*)(ws + WS_CTL) + CW_TEXP, (int*)(ws + WS_CTL) + CW_NTILES); }
        SEAM(pb + 6);
        if (IN(pb + 7)) { WSP(ws); const int nt = (int)__hip_atomic_load((gu32*)(ws + WS_CTL) + CW_NTILES, RLX_AGENT);
            pg8::Gemm g{(const bf16*)(ws + WS_R1), (const bf16*)(ws + WS_WGU) + (size_t)l * NE * 1024 * D, XP_ROWS, NE * 1024, D}; pg8::GroupedOrder S{(const int*)(ws + WS_CTL) + CW_TEXP, nt * 4, F.G, (int)blockIdx.x};
            pg8::EpiSiluMul E{(bf16*)(ws + WS_HID), FF}; GEMM_PHASE(pg8::EpiSiluMul, pg8::GroupedOrder, g, S, E); }
        SEAM(pb + 7);
        if (IN(pb + 8)) { WSP(ws); const int nt = (int)__hip_atomic_load((gu32*)(ws + WS_CTL) + CW_NTILES, RLX_AGENT);
            pg8::Gemm g{(const bf16*)(ws + WS_HID), (const bf16*)(ws + WS_WD) + (size_t)l * NE * D * FF, XP_ROWS, NE * 1024, FF}; pg8::GroupedOrder S{(const int*)(ws + WS_CTL) + CW_TEXP, nt * 4, F.G, (int)blockIdx.x};
            pg8::EpiF32 E{(float*)(ws + WS_R2), D, 3}; GEMM_PHASE(pg8::EpiF32, pg8::GroupedOrder, g, S, E); }
        SEAM(pb + 8);
        if (IN(pb + 9)) { WSP(ws); ln_ffn_phase(F, args.out, (const float*)(ws + WS_R2), (const int*)(ws + WS_TAB_SO), (const float*)(ws + WS_TAB_SW), MODL(ws, l), args.in[7] + l * D, args.in[8] + l * D,
                                                  l + 1 < DEPTH ? MODL(ws, l + 1) : (const float*)nullptr, (bf16*)(ws + WS_HB)); }
        SEAM2(pb + 9, pb + 16);
    }
#undef IN
}
}

#ifndef MK_SPLIT
#define MK_SPLIT 0
#endif
extern "C" void kernel_launch(void* const* d_in, const int* in_sizes, int n_in, void* d_out, int out_size, void* d_ws, size_t ws_size, hipStream_t stream) {
    static int grid = 0;
    if (grid == 0) {
        if (ws_size < WS_END2 || n_in != 30) { fprintf(stderr, "kernel_launch: ws %zu < %zu or n_in %d\n", ws_size, (size_t)WS_END2, n_in); grid = -1; return; }
        int dev = 0, cus = 0;
        if (hipGetDevice(&dev) != hipSuccess || hipDeviceGetAttribute(&cus, hipDeviceAttributeMultiprocessorCount, dev) != hipSuccess) { grid = -1; return; }
        if (hipFuncSetAttribute((const void*)mega, hipFuncAttributeMaxDynamicSharedMemorySize, LDS_BYTES) != hipSuccess) { fprintf(stderr, "kernel_launch: hipFuncSetAttribute failed\n"); grid = -1; return; }
        int per_cu = 0;
        if (hipOccupancyMaxActiveBlocksPerMultiprocessor(&per_cu, (const void*)mega, NWAVES * 64, LDS_BYTES) != hipSuccess || per_cu < 1) fprintf(stderr, "kernel_launch: occupancy query reports %d blocks per CU\n", per_cu);
        (void)hipGetLastError();
        grid = cus;
    }
    if (grid < 0) return;
    unsigned char* ws = (unsigned char*)d_ws;
    (void)hipMemsetAsync(ws + WS_CTL, 0, CTL_ZERO_BYTES, stream);
    Args a{};
    for (int i = 0; i < 30; ++i) a.in[i] = (const float*)d_in[i];
    a.out = (float*)d_out; a.ws = ws;
    const int NPH = 2 + 16 * DEPTH;
#if MK_SPLIT
    int li = 0;
    for (int p = 0; p < NPH; ++p) {
        const int r = (p - 2) & 15; if (p >= 2 && (r >= 10 || (r == 2 && (((p - 2) >> 4) & 1)))) continue;
        a.ph_lo = p; a.ph_hi = p + 1; a.li = li++; hipLaunchKernelGGL(mega, dim3(grid), dim3(NWAVES * 64), LDS_BYTES, stream, a);
    }
#else
    a.ph_lo = 0; a.ph_hi = NPH; a.li = 0;
    hipLaunchKernelGGL(mega, dim3(grid), dim3(NWAVES * 64), LDS_BYTES, stream, a);
#endif
}
```

```cpp
#include <hip/hip_runtime.h>
#include <cstdio>
#include <cstdint>
namespace pg8 {
#define PG8_LAS __attribute__((address_space(3)))
typedef unsigned short bf16_t;
typedef short bf16x8 __attribute__((ext_vector_type(8)));
typedef float f32x4 __attribute__((ext_vector_type(4)));
typedef unsigned u32x4 __attribute__((ext_vector_type(4)));
constexpr int BM = 256, BK = 64, HALF = 128, HTB = HALF * BK * 2  , STAGE_BYTES = 8 * HTB, NXCD = 8, WGM = 8;

__host__ __device__ __forceinline__ int lds_byte(int r, int c) { const int st = (r >> 4) * 2 + (c >> 5), rr = r & 15, cc = c & 31, ob = rr * 64 + cc * 2; return st * 1024 + (ob ^ (((ob >> 9) & 1) << 5)); }
__host__ __device__ __forceinline__ void stage_rc(int b, int& R, int& C) { const int st = b / 1024, sb = b % 1024, swz = sb ^ (((sb >> 9) & 1) << 5); R = (st >> 1) * 16 + swz / 64; C = (st & 1) * 32 + (swz % 64) / 2; }
__host__ __device__ __forceinline__ int perm32(int rho) { const int n = rho >> 4, i = rho & 15; return 8 * (i >> 2) + 4 * n + (i & 3); }

struct Unit { int pm, pn; };
struct Gemm { const bf16_t* A; const bf16_t* Bt; int M, N, K; };

struct StaticOrder {
    int nM, nN, nwg, G, c;
    __host__ __device__ void init(int M, int N, int G_, int c_) { nM = M / BM; nN = N / BM; nwg = nM * nN; G = G_; c = c_; }
    __host__ __device__ bool next(int i, Unit& u) const {
        const long L = (long)i * G + c; if (L >= nwg) return false;
        int wgid = (int)L; { const int q = nwg / NXCD, r = nwg % NXCD, xcd = wgid % NXCD, off = wgid / NXCD; wgid = (xcd < r ? xcd * (q + 1) : r * (q + 1) + (xcd - r) * q) + off; }
        const int nig = WGM * nN, gid = wgid / nig, fm = gid * WGM, gsz = (nM - fm) < WGM ? (nM - fm) : WGM;
        u.pm = fm + ((wgid % nig) % gsz); u.pn = (wgid % nig) / gsz; return true;
    }
    __device__ __forceinline__ void a_ready(const Unit&) const {}
    __device__ __forceinline__ void done(const Unit&) const {}
};

__device__ __forceinline__ unsigned cvt_pk_bf16(float lo, float hi) { unsigned r; asm volatile("v_cvt_pk_bf16_f32 %0, %1, %2" : "=v"(r) : "v"(lo), "v"(hi)); return r; }
typedef float f32x2 __attribute__((ext_vector_type(2)));
typedef unsigned u32x2 __attribute__((ext_vector_type(2)));
struct EpiF32 {
    static constexpr bool PERM = false, AFTER_DRAIN = false;
    float* C; int ldc; int pn_mask;
    __device__ __forceinline__ void operator()(const f32x4 (&acc)[2][2][4][2], const Unit& u, int wr, int wc, int fr, int fq) const {
        const int row0 = u.pm * BM + wr * 64 + fr, col0 = (u.pn & pn_mask) * BM + wc * 32 + 4 * fq;
#pragma unroll
        for (int ai = 0; ai < 2; ++ai)
#pragma unroll
            for (int m = 0; m < 4; ++m) { float* rowp = C + (size_t)(row0 + ai * HALF + m * 16) * ldc + col0;
#pragma unroll
                for (int bj = 0; bj < 2; ++bj)
#pragma unroll
                    for (int n = 0; n < 2; ++n) *(f32x4*)(rowp + bj * HALF + n * 16) = acc[ai][bj][m][n]; }
    }
};
struct EpiB16 {
    static constexpr bool PERM = false, AFTER_DRAIN = false;
    bf16_t* O; int ldc; int pn_mask;
    __device__ __forceinline__ void operator()(const f32x4 (&acc)[2][2][4][2], const Unit& u, int wr, int wc, int fr, int fq) const {
        const int row0 = u.pm * BM + wr * 64 + fr, col0 = (u.pn & pn_mask) * BM + wc * 32 + 4 * fq;
#pragma unroll
        for (int ai = 0; ai < 2; ++ai)
#pragma unroll
            for (int m = 0; m < 4; ++m) { bf16_t* rowp = O + (size_t)(row0 + ai * HALF + m * 16) * ldc + col0;
#pragma unroll
                for (int bj = 0; bj < 2; ++bj)
#pragma unroll
                    for (int n = 0; n < 2; ++n) { const f32x4 v = acc[ai][bj][m][n]; u32x2 w; w.x = cvt_pk_bf16(v[0], v[1]); w.y = cvt_pk_bf16(v[2], v[3]); *(u32x2*)(rowp + bj * HALF + n * 16) = w; } }
    }
};
struct EpiSiluMul {
    static constexpr bool PERM = false, AFTER_DRAIN = false;
    bf16_t* O; int ldc;
    __device__ __forceinline__ void operator()(const f32x4 (&acc)[2][2][4][2], const Unit& u, int wr, int wc, int fr, int fq) const {
        const int row0 = u.pm * BM + wr * 64 + fr, f0 = ((u.pn & 3) * 8 + wc) * 16 + 4 * fq;
#pragma unroll
        for (int ai = 0; ai < 2; ++ai)
#pragma unroll
            for (int m = 0; m < 4; ++m) { bf16_t* rowp = O + (size_t)(row0 + ai * HALF + m * 16) * ldc + f0;
#pragma unroll
                for (int bj = 0; bj < 2; ++bj) { const f32x4 g = acc[ai][bj][m][0], up = acc[ai][bj][m][1]; f32x4 r;
#pragma unroll
                    for (int j = 0; j < 4; ++j) r[j] = g[j] * __builtin_amdgcn_rcpf(1.f + __expf(-g[j])) * up[j];
                    u32x2 w; w.x = cvt_pk_bf16(r[0], r[1]); w.y = cvt_pk_bf16(r[2], r[3]); *(u32x2*)(rowp + bj * 64) = w; } }
    }
};
struct EpiQuk {
    static constexpr bool PERM = false, AFTER_DRAIN = false;
    bf16_t* O; int ldc; const float* csm;
    __device__ __forceinline__ void operator()(const f32x4 (&acc)[2][2][4][2], const Unit& u, int wr, int wc, int fr, int fq) const {
        const int row0 = u.pm * BM + wr * 64 + fr; const float QS = 0.14724270f;
#pragma unroll
        for (int ai = 0; ai < 2; ++ai)
#pragma unroll
            for (int m = 0; m < 4; ++m) { const int row = row0 + ai * HALF + m * 16;
#pragma unroll
                for (int bj = 0; bj < 2; ++bj) { const int G32 = u.pn * 8 + bj * 4 + wc;
                    f32x4 v0 = acc[ai][bj][m][0], v1 = acc[ai][bj][m][1];
                    if (G32 < 24) {
                        if (G32 % 3 == 2) { const float* cs = csm + ((size_t)row * 16 + 4 * fq) * 2; const f32x4 c0 = *(const f32x4*)cs, c1 = *(const f32x4*)(cs + 4);
                            const f32x4 cc = {c0[0], c0[2], c1[0], c1[2]}, ss = {c0[1], c0[3], c1[1], c1[3]};
                            const f32x4 o1 = v0 * cc - v1 * ss, o2 = v0 * ss + v1 * cc; v0 = o1; v1 = o2; }
                        v0 = v0 * QS; v1 = v1 * QS;
                    }
                    bf16_t* p = O + (size_t)row * ldc + G32 * 32 + 4 * fq;
                    u32x2 w0; w0.x = cvt_pk_bf16(v0[0], v0[1]); w0.y = cvt_pk_bf16(v0[2], v0[3]); *(u32x2*)p = w0;
                    u32x2 w1; w1.x = cvt_pk_bf16(v1[0], v1[1]); w1.y = cvt_pk_bf16(v1[2], v1[3]); *(u32x2*)(p + 16) = w1; } }
    }
};
struct EpiRet {
    static constexpr bool PERM = false, AFTER_DRAIN = false;
    bf16_t* O; int ldc; const float* csr;
    __device__ __forceinline__ void operator()(const f32x4 (&acc)[2][2][4][2], const Unit& u, int wr, int wc, int fr, int fq) const {
        const int row0 = u.pm * BM + wr * 64 + fr;
#pragma unroll
        for (int ai = 0; ai < 2; ++ai)
#pragma unroll
            for (int m = 0; m < 4; ++m) { const int row = row0 + ai * HALF + m * 16;
#pragma unroll
                for (int bj = 0; bj < 2; ++bj) { const int G32 = u.pn * 8 + bj * 4 + wc;
                    f32x4 v0 = acc[ai][bj][m][0], v1 = acc[ai][bj][m][1];
                    if (G32 < 64) { const float* cs = csr + ((size_t)row * 64 + 16 * (G32 & 3) + 4 * fq) * 2; const f32x4 c0 = *(const f32x4*)cs, c1 = *(const f32x4*)(cs + 4);
                        const f32x4 cc = {c0[0], c0[2], c1[0], c1[2]}, ss = {c0[1], c0[3], c1[1], c1[3]};
                        f32x4 o1 = v0 * cc - v1 * ss, o2 = v0 * ss + v1 * cc;
                        if (G32 < 32) { o1 = o1 * 0.08838834764831845f; o2 = o2 * 0.08838834764831845f; }
                        v0 = o1; v1 = o2; }
                    bf16_t* p = O + (size_t)row * ldc + G32 * 32 + 4 * fq;
                    u32x2 w0; w0.x = cvt_pk_bf16(v0[0], v0[1]); w0.y = cvt_pk_bf16(v0[2], v0[3]); *(u32x2*)p = w0;
                    u32x2 w1; w1.x = cvt_pk_bf16(v1[0], v1[1]); w1.y = cvt_pk_bf16(v1[2], v1[3]); *(u32x2*)(p + 16) = w1; } }
    }
};
struct GroupedOrder {
    const PG8_LAS int* tab; const int* tok_of; int n_units, G, c;
    __device__ bool next(int i, Unit& u) const { const int L = i * G + c; if (L >= n_units) return false; const int rt = L >> 2; u.pm = rt; u.pn = tab[64 + rt] * 4 + (L & 3); return true; }
    __device__ __forceinline__ int row_token(const Unit& u, int row) const {
        const int e = u.pn >> 2, pos = (u.pm - tab[e]) * BM + row; return pos < tab[256 + e] ? tok_of[e * 16384 + pos] : 0; }
    __device__ __forceinline__ void a_ready(const Unit&) const {}
    __device__ __forceinline__ void done(const Unit&) const {}
};
template <class Epi, class Sched, bool ALIGN_EPI = false, bool SP2 = false, bool GATHER = false>
__device__ __forceinline__ void gemm_phase(PG8_LAS unsigned char* lds, const Gemm g, const Sched& S, const Epi& E) {
    int tid_ = threadIdx.x; asm volatile("" : "+v"(tid_));
    const int tid = tid_, wid = __builtin_amdgcn_readfirstlane(tid >> 6), lane = tid & 63, wr = wid >> 2, wc = wid & 3, fr = lane & 15, fq = lane >> 4;
    int K_ = g.K; asm volatile("" : "+s"(K_));
    const int K = K_, nt = K / BK;
    unsigned voffA[2], voffB[2];
#pragma unroll
    for (int i = 0; i < 2; ++i) { int R, C; stage_rc(tid * 16 + i * 8192, R, C); const int Rb = Epi::PERM ? ((R & ~31) + perm32(R & 31)) : R;
        voffA[i] = (unsigned)(R * K + C) * 2u; voffB[i] = (unsigned)(Rb * K + C) * 2u; }
    static_assert(!GATHER || SP2, "GATHER is wired into the SP2 loop only");
    unsigned gcu[2] = {0u, 0u}, gnx[2] = {0u, 0u};
#define PG8_GOFF(dst, U) do { if constexpr (GATHER) { _Pragma("unroll") for (int _h = 0; _h < 2; ++_h) { int _R0, _R1, _C; stage_rc(tid * 16, _R0, _C); stage_rc(tid * 16 + 8192, _R1, _C); \
        dst[_h] = (unsigned)S.row_token(U, _h * HALF + _R0) | ((unsigned)S.row_token(U, _h * HALF + _R1) << 16); } } } while (0)
#define PG8_STAGE_A(bufoff, hf, kt, usenext) do { if constexpr (GATHER) { const char* _b = (const char*)g.A + (size_t)(kt) * kstep; const unsigned _p = (usenext) ? gnx[hf] : gcu[hf]; unsigned _v[2]; \
        { int _R, _C0, _C1; stage_rc(tid * 16, _R, _C0); stage_rc(tid * 16 + 8192, _R, _C1); _v[0] = ((_p & 0xffffu) * (unsigned)K + (unsigned)_C0) * 2u; _v[1] = ((_p >> 16) * (unsigned)K + (unsigned)_C1) * 2u; } \
        PG8_STAGE(bufoff, _b, _v); } \
        else { PG8_STAGE(bufoff, ((usenext) ? nA_ : cA) + (hf) * hstep + (size_t)(kt) * kstep, voffA); } } while (0)
    const size_t kstep = (size_t)(BK * 2);
    const size_t hstep = (size_t)HALF * K * 2;
    const size_t tstep = 2 * hstep;
    const unsigned ldsw = (unsigned)wid * 1024u;
    const int aoff = lds_byte(wr * 64 + fr, fq * 8), boff = lds_byte(wc * 32 + fr, fq * 8);
#define PG8_SA(b, h) (((b) * 2 + (h)) * HTB)
#define PG8_SB(b, h) ((4 + (b) * 2 + (h)) * HTB)
#define PG8_STAGE(bufoff, gbase, voff) do { _Pragma("unroll") for (int _i = 0; _i < 2; ++_i) \
        __builtin_amdgcn_global_load_lds((const unsigned*)((const char*)(gbase) + (voff)[_i]), (PG8_LAS unsigned*)(lds + (bufoff) + ldsw + _i * 8192), 16, 0, 0); } while (0)
#define PG8_LDA(dst, b, h) do { _Pragma("unroll") for (int m = 0; m < 4; ++m) _Pragma("unroll") for (int k = 0; k < 2; ++k) dst[m][k] = *(const PG8_LAS bf16x8*)(lds + PG8_SA(b, h) + aoff + m * 2048 + k * 1024); } while (0)
#define PG8_LDB(dst, b, h) do { _Pragma("unroll") for (int n = 0; n < 2; ++n) _Pragma("unroll") for (int k = 0; k < 2; ++k) dst[n][k] = *(const PG8_LAS bf16x8*)(lds + PG8_SB(b, h) + boff + n * 2048 + k * 1024); } while (0)
#define PG8_MMA(ai, bj, At, Bt) do { __builtin_amdgcn_s_setprio(1); _Pragma("unroll") for (int m = 0; m < 4; ++m) _Pragma("unroll") for (int n = 0; n < 2; ++n) _Pragma("unroll") for (int k = 0; k < 2; ++k) \
        acc[ai][bj][m][n] = __builtin_amdgcn_mfma_f32_16x16x32_bf16(Bt[n][k], At[m][k], acc[ai][bj][m][n], 0, 0, 0); __builtin_amdgcn_s_setprio(0); } while (0)
#define PG8_WAIT_V(n) asm volatile("s_waitcnt vmcnt(" #n ")" ::: "memory")
#define PG8_WAIT_L(n) asm volatile("s_waitcnt lgkmcnt(" #n ")" ::: "memory")
#define PG8_BAR __builtin_amdgcn_s_barrier()
#define PG8_SCHED __builtin_amdgcn_sched_barrier(0)
    Unit cur, nxt; int ui = 0;
    if (!S.next(0, cur)) return;
    f32x4 acc[2][2][4][2];
#pragma unroll
    for (int a = 0; a < 2; ++a)
#pragma unroll
        for (int b = 0; b < 2; ++b)
#pragma unroll
            for (int m = 0; m < 4; ++m)
#pragma unroll
                for (int n = 0; n < 2; ++n) acc[a][b][m][n] = (f32x4){0.f, 0.f, 0.f, 0.f};
    bf16x8 At[4][2], B0[2][2], B1[2][2];
    const char* cA = (const char*)g.A + (size_t)cur.pm * tstep; const char* cB = (const char*)g.Bt + (size_t)cur.pn * tstep;
    const char* nA_ = cA;
    PG8_GOFF(gcu, cur);
    S.a_ready(cur);
    if constexpr (SP2) {
        PG8_STAGE(PG8_SB(0, 0), cB, voffB); PG8_STAGE(PG8_SB(0, 1), cB + hstep, voffB); PG8_STAGE_A(PG8_SA(0, 0), 0, 0, false); PG8_STAGE_A(PG8_SA(0, 1), 1, 0, false);
        if (wr == 1) PG8_BAR;
        PG8_WAIT_V(2); PG8_BAR;
        PG8_STAGE(PG8_SB(1, 0), cB + kstep, voffB); PG8_STAGE_A(PG8_SA(1, 0), 0, 1, false); PG8_STAGE(PG8_SB(1, 1), cB + hstep + kstep, voffB);
        PG8_WAIT_V(6); PG8_BAR;
    } else {
        PG8_STAGE(PG8_SB(0, 0), cB, voffB); PG8_STAGE(PG8_SA(0, 0), cA, voffA); PG8_STAGE(PG8_SB(0, 1), cB + hstep, voffB); PG8_STAGE(PG8_SA(0, 1), cA + hstep, voffA);
        if (wr == 1) PG8_BAR;
        PG8_WAIT_V(4); PG8_BAR;
        PG8_STAGE(PG8_SB(1, 0), cB + kstep, voffB); PG8_STAGE(PG8_SA(1, 0), cA + kstep, voffA); PG8_STAGE(PG8_SB(1, 1), cB + hstep + kstep, voffB);
        PG8_WAIT_V(6); PG8_BAR;
    }
    for (;;) {
        const bool has_next = S.next(ui + 1, nxt);
        const char* nA = has_next ? (const char*)g.A + (size_t)nxt.pm * tstep : cA; const char* nB = has_next ? (const char*)g.Bt + (size_t)nxt.pn * tstep : cB;
        nA_ = nA;
        if constexpr (GATHER) { if (has_next) PG8_GOFF(gnx, nxt); else { gnx[0] = gcu[0]; gnx[1] = gcu[1]; } }
        for (int t = 0; t < nt; t += 2) {
            const bool last = (t == nt - 2);
            const char* a1 = cA + (size_t)(t + 1) * kstep;
            const char* a2 = last ? nA : cA + (size_t)(t + 2) * kstep; const char* b2 = last ? nB : cB + (size_t)(t + 2) * kstep;
            const char* a3 = a2 + kstep; const char* b3 = b2 + kstep;
            if (last && has_next) S.a_ready(nxt);
            if constexpr (SP2) {
            PG8_LDB(B0, 0, 0); PG8_LDB(B1, 0, 1); PG8_SCHED; PG8_LDA(At, 0, 0); PG8_STAGE_A(PG8_SA(1, 1), 1, t + 1, false);
            PG8_WAIT_V(8); PG8_WAIT_L(0); PG8_BAR; PG8_MMA(0, 0, At, B0); PG8_MMA(0, 1, At, B1); PG8_BAR; PG8_SCHED;
            PG8_LDA(At, 0, 1); PG8_STAGE(PG8_SB(0, 0), b2, voffB); PG8_STAGE(PG8_SB(0, 1), b2 + hstep, voffB); PG8_STAGE_A(PG8_SA(0, 0), 0, last ? 0 : t + 2, last);
            PG8_WAIT_V(8); PG8_WAIT_L(0); PG8_BAR; PG8_MMA(1, 0, At, B0); PG8_MMA(1, 1, At, B1); PG8_BAR; PG8_SCHED;
            PG8_LDB(B0, 1, 0); PG8_LDB(B1, 1, 1); PG8_SCHED; PG8_LDA(At, 1, 0); PG8_STAGE_A(PG8_SA(0, 1), 1, last ? 0 : t + 2, last);
            PG8_WAIT_V(8); PG8_WAIT_L(0); PG8_BAR; PG8_MMA(0, 0, At, B0); PG8_MMA(0, 1, At, B1); PG8_BAR; PG8_SCHED;
            PG8_LDA(At, 1, 1); PG8_STAGE(PG8_SB(1, 0), b3, voffB); PG8_STAGE(PG8_SB(1, 1), b3 + hstep, voffB); PG8_STAGE_A(PG8_SA(1, 0), 0, last ? 1 : t + 3, last);
            PG8_WAIT_V(8); PG8_WAIT_L(0); PG8_BAR; PG8_MMA(1, 0, At, B0); PG8_MMA(1, 1, At, B1); PG8_BAR; PG8_SCHED;
            } else {
            PG8_LDB(B0, 0, 0); PG8_SCHED; PG8_LDA(At, 0, 0); PG8_STAGE(PG8_SA(1, 1), a1 + hstep, voffA);
            PG8_WAIT_L(8); PG8_BAR; PG8_WAIT_L(0); PG8_MMA(0, 0, At, B0); PG8_BAR; PG8_SCHED;
            PG8_LDB(B1, 0, 1); PG8_STAGE(PG8_SB(0, 0), b2, voffB);
            PG8_BAR; PG8_WAIT_L(0); PG8_MMA(0, 1, At, B1); PG8_BAR;
            PG8_LDA(At, 0, 1); PG8_STAGE(PG8_SA(0, 0), a2, voffA);
            PG8_BAR; PG8_WAIT_L(0); PG8_MMA(1, 0, At, B0); PG8_BAR; PG8_SCHED;
            PG8_STAGE(PG8_SB(0, 1), b2 + hstep, voffB);
            PG8_WAIT_V(6); PG8_BAR; PG8_MMA(1, 1, At, B1); PG8_BAR;
            PG8_LDB(B0, 1, 0); PG8_SCHED; PG8_LDA(At, 1, 0); PG8_STAGE(PG8_SA(0, 1), a2 + hstep, voffA);
            PG8_WAIT_L(8); PG8_BAR; PG8_WAIT_L(0); PG8_MMA(0, 0, At, B0); PG8_BAR; PG8_SCHED;
            PG8_LDB(B1, 1, 1); PG8_STAGE(PG8_SB(1, 0), b3, voffB);
            PG8_BAR; PG8_WAIT_L(0); PG8_MMA(0, 1, At, B1); PG8_BAR;
            PG8_LDA(At, 1, 1); PG8_STAGE(PG8_SA(1, 0), a3, voffA);
            PG8_BAR; PG8_WAIT_L(0); PG8_MMA(1, 0, At, B0); PG8_BAR; PG8_SCHED;
            PG8_STAGE(PG8_SB(1, 1), b3 + hstep, voffB);
            PG8_WAIT_V(6); PG8_BAR; PG8_MMA(1, 1, At, B1); PG8_BAR;
            }
        }
        if constexpr (ALIGN_EPI) { if (wr == 0) PG8_BAR; }
        if constexpr (!Epi::AFTER_DRAIN) { E(acc, cur, wr, wc, fr, fq); S.done(cur); }
        if (!has_next) break;
#pragma unroll
        for (int a = 0; a < 2; ++a)
#pragma unroll
            for (int b = 0; b < 2; ++b)
#pragma unroll
                for (int m = 0; m < 4; ++m)
#pragma unroll
                    for (int n = 0; n < 2; ++n) acc[a][b][m][n] = (f32x4){0.f, 0.f, 0.f, 0.f};
        cur = nxt; cA = nA; cB = nB; ++ui;
        if constexpr (GATHER) { gcu[0] = gnx[0]; gcu[1] = gnx[1]; }
        if constexpr (ALIGN_EPI) { if (wr == 1) PG8_BAR; }
    }
    PG8_WAIT_V(0);
    if constexpr (!ALIGN_EPI) { if (wr == 0) PG8_BAR; }
    PG8_BAR;
    if constexpr (Epi::AFTER_DRAIN) { E.fused(acc, cur, wr, wc, fr, fq, lds, wid, lane); S.done(cur); }
#undef PG8_GOFF
#undef PG8_STAGE_A
#undef PG8_SA
#undef PG8_SB
#undef PG8_STAGE
#undef PG8_LDA
#undef PG8_LDB
#undef PG8_MMA
#undef PG8_WAIT_V
#undef PG8_WAIT_L
#undef PG8_BAR
#undef PG8_SCHED
}
}
#define PG8_SP2 true
#define PG8_ALIGN true
#define GAS __attribute__((address_space(1)))
#define LAS __attribute__((address_space(3)))
typedef unsigned short bf16;
typedef unsigned v4u __attribute__((ext_vector_type(4)));
typedef float f32x4 __attribute__((ext_vector_type(4)));
typedef short bf16x8 __attribute__((ext_vector_type(8)));
typedef GAS unsigned gu32;
typedef GAS unsigned long long gu64;
#define RLX_AGENT __ATOMIC_RELAXED, __HIP_MEMORY_SCOPE_AGENT
#define LDS_WAIT() asm volatile("s_waitcnt lgkmcnt(0)" ::: "memory")
#define VM_WAIT() asm volatile("s_waitcnt vmcnt(0)" ::: "memory")
__device__ __forceinline__ unsigned long long rt() { return __builtin_amdgcn_s_memrealtime(); }
__device__ __forceinline__ unsigned f2bf(float f) { unsigned u = __builtin_bit_cast(unsigned, f); return (u + 0x7fffu + ((u >> 16) & 1u)) >> 16; }
__device__ __forceinline__ unsigned pk2(float lo, float hi) { return f2bf(lo) | (f2bf(hi) << 16); }

#define XB_TMO      128
#define XB_XCNT(j)  (256  + 64 * (j))
#define XB_XSUB(j)  (1280 + 64 * (j))
#define XB_XGEN(j)  (2304 + 64 * (j))
#define XB_TOP      3328
#define XB_TOPGEN   3392
#define XCD_BAR_WORDS 3456
#define XB_SPIN_CAP (1u << 18)

__device__ __forceinline__ unsigned xb_ld(unsigned* p)              { return __hip_atomic_load(p, __ATOMIC_RELAXED, __HIP_MEMORY_SCOPE_AGENT); }
__device__ __forceinline__ unsigned xb_add(unsigned* p, unsigned v) { return __hip_atomic_fetch_add(p, v, __ATOMIC_RELAXED, __HIP_MEMORY_SCOPE_AGENT); }
__device__ __forceinline__ unsigned xb_xcc_id() { return (unsigned)__builtin_amdgcn_s_getreg((3 << 11) | 20) & 0xFu; }
#define XB_SPIN(cond, bar) do { unsigned _sp = 0; while (cond) { __builtin_amdgcn_s_sleep(1); \
    if ((++_sp & 255u) == 0u) { if (xb_ld(&(bar)[XB_TMO])) break; if (_sp > XB_SPIN_CAP) { atomicAdd(&(bar)[XB_TMO], 1u); break; } } } } while (0)

struct XcdBarrier {
    unsigned* bar; unsigned x;
    volatile LAS unsigned* st;
};

__device__ __forceinline__ XcdBarrier xcd_barrier_post(unsigned* bar, volatile LAS unsigned* st) {
    XcdBarrier b; b.bar = bar; b.x = xb_xcc_id(); b.st = st;
    if (threadIdx.x == 0) (void)xb_add(&bar[XB_XCNT(b.x)], 1u);
    return b;
}
__device__ __forceinline__ void xcd_barrier_complete(unsigned* bar, unsigned x, unsigned& nloc, unsigned& nx) {
    const unsigned G = gridDim.x * gridDim.y * gridDim.z;
    unsigned sum, cnt, mine, sp = 0u;
    for (;;) {
        sum = 0u; cnt = 0u; mine = 0u;
#pragma unroll
        for (unsigned j = 0; j < 16; ++j) { const unsigned c = xb_ld(&bar[XB_XCNT(j)]); sum += c; cnt += (c > 0u) ? 1u : 0u; mine = (j == x) ? c : mine; }
        if (sum == G) break;
        __builtin_amdgcn_s_sleep(1);
        if ((++sp & 255u) == 0u) { if (xb_ld(&bar[XB_TMO])) break; if (sp > XB_SPIN_CAP) { atomicAdd(&bar[XB_TMO], 1u); break; } }
    }
    nloc = mine > 0u ? mine : 1u; nx = cnt > 0u ? cnt : 1u;
}

__device__ __forceinline__ void xcd_barrier(const XcdBarrier& b) {
    asm volatile("s_waitcnt vmcnt(0)" ::: "memory");
    __syncthreads();
    if (threadIdx.x == 0) {
        unsigned* bar = b.bar;
        __builtin_amdgcn_s_waitcnt(0);
        unsigned nloc = b.st[0], nx = b.st[1];
        if (nloc == 0u) { xcd_barrier_complete(bar, b.x, nloc, nx); b.st[0] = nloc; b.st[1] = nx; }
        const unsigned old = xb_add(&bar[XB_XSUB(b.x)], 1u);
        const unsigned gen = old / nloc;
        if (old + 1u == (gen + 1u) * nloc) {
            __builtin_amdgcn_fence(__ATOMIC_RELEASE, "agent");
            asm volatile("s_waitcnt vmcnt(0)" ::: "memory");
            const unsigned og = xb_add(&bar[XB_TOP], 1u);
            const unsigned tg = og / nx;
            if (og + 1u == (tg + 1u) * nx) xb_add(&bar[XB_TOPGEN], 1u);
            else XB_SPIN(xb_ld(&bar[XB_TOPGEN]) == tg, bar);
            __builtin_amdgcn_fence(__ATOMIC_ACQUIRE, "agent");
            xb_add(&bar[XB_XGEN(b.x)], 1u);
            asm volatile("s_waitcnt vmcnt(0)" ::: "memory");
        } else {
            XB_SPIN(xb_ld(&bar[XB_XGEN(b.x)]) == gen, bar);
            __builtin_amdgcn_fence(__ATOMIC_ACQUIRE, "agent");
            asm volatile("s_waitcnt vmcnt(0)" ::: "memory");
        }
    }
    __syncthreads();
}

namespace {
constexpr int D = 1024, NB = 4, SEQ = 4096, T = NB * SEQ, DEPTH = 4;
constexpr int MLA_COLS = 416, HY_IN = 2480, HY_LD = 2560, UP_K = 384, UP_N = 1792;
constexpr int RET_IN = 6144, RET_MIX = 2048;
constexpr int NG = 4, NE = 32, FF = 512;
constexpr int XP_ROWS = 2 * T + NE * 256;
constexpr float LN_EPS = 1e-5f, RMS_EPS = 1e-6f;
constexpr float ALPHA = 1.681792830507429f;
constexpr size_t MiB = 1u << 20;
constexpr size_t WS_CTL = 0, CTL_ZERO_BYTES = 1 * MiB;
constexpr size_t WS_MOD = 1 * MiB, WS_TAB = 1 * MiB + 512 * 1024;
constexpr size_t WS_HB = 2 * MiB, WS_Y = 34 * MiB;
constexpr size_t WS_WIN = 98 * MiB, WS_WUP = 108 * MiB, WS_WOUT = 111 * MiB, WS_RIN = 115 * MiB, WS_ROUT = 139 * MiB, WS_WGU = 147 * MiB, WS_WD = 403 * MiB;
constexpr size_t WS_R1 = 531 * MiB, WS_R2 = 723 * MiB, WS_END = 883 * MiB;
constexpr size_t WS_UPA = WS_R1 + 80 * MiB, WS_QUK = WS_R1 + 92 * MiB, WS_KR = WS_R1 + 150 * MiB, WS_HID = WS_R1 + 80 * MiB, WS_ST = WS_R2 + 64 * MiB, WS_GD = WS_R2 + 32 * MiB, WS_GL = WS_R2 + 112 * MiB;
constexpr size_t WS_CSM = 883 * MiB, WS_CSR = 885 * MiB, WS_TOK = 893 * MiB  , WS_END2 = 895 * MiB, WS_TAB_SE = WS_TAB, WS_TAB_SP = WS_TAB + 128 * 1024, WS_TAB_SO = WS_TAB + 256 * 1024, WS_TAB_SW = WS_TAB + 384 * 1024;
constexpr int CW_TMO = 0, CW_CODE = 1, CW_NTILES = 128, CW_TEXP = 192  , CW_CNT = 1024  , CW_AQ = 2048  , CW_BAR = 8192;
constexpr int RING_OFF = 0, RING_BYTES = 162816, LDSCTL_OFF = RING_BYTES, MISC_OFF = LDSCTL_OFF + 320, LDS_BYTES = 163840;
constexpr int NWAVES = 8;
constexpr int MOE_TAB_OFF = 135168;

__device__ __forceinline__ float silu_f(float x) { return x * __builtin_amdgcn_rcpf(1.f + __builtin_amdgcn_exp2f(-1.4426950408889634f * x)); }
__device__ __forceinline__ float bf2f(bf16 v) { return __uint_as_float(((unsigned)v) << 16); }
__device__ __forceinline__ bf16 f2b(float f) { return (bf16)f2bf(f); }

struct Args { const float* in[30]; float* out; unsigned char* ws; int ph_lo, ph_hi, li, pad; };
struct Frame {
    LAS unsigned char* lds; volatile LAS unsigned* MISC; gu32* ctl;
    int tid, lane, wave, vcu, G;
};
template <class F> __device__ __forceinline__ void tr_item(F src, int K, bf16* WT, int k0, int n0, LAS float* scr, int lane) {
    float tv[32];
#pragma unroll
    for (int i = 0; i < 32; ++i) tv[i] = src(n0 + (lane & 31), k0 + 2 * i + (lane >> 5));
#pragma unroll
    for (int i = 0; i < 32; ++i) { const int kk = 2 * i + (lane >> 5); scr[kk * 33 + (lane & 31)] = tv[i]; }
    LDS_WAIT(); asm volatile("" ::: "memory");
    const int c = lane & 7;
#pragma unroll
    for (int j = 0; j < 4; ++j) { const int n = (lane >> 3) + 8 * j; const LAS float* s = scr + (8 * c) * 33 + n;
        v4u o; o.x = pk2(s[0 * 33], s[1 * 33]); o.y = pk2(s[2 * 33], s[3 * 33]); o.z = pk2(s[4 * 33], s[5 * 33]); o.w = pk2(s[6 * 33], s[7 * 33]);
        *(GAS v4u*)(WT + (size_t)(n0 + n) * K + k0 + 8 * c) = o; }
    LDS_WAIT(); asm volatile("" ::: "memory");
}
__device__ __forceinline__ void p0_weights(Frame& F, const Args& a) {
    LAS float* scr = (LAS float*)(F.lds + RING_OFF + F.wave * 16384);
    int tid_ = threadIdx.x; asm volatile("" : "+v"(tid_));
    const int gw = F.vcu * NWAVES + F.wave, NGW = F.G * NWAVES, lane = tid_ & 63;
    unsigned char* ws = a.ws;
    constexpr int I_WIN = (D / 64) * (HY_LD / 32), I_WUP = (UP_K / 64) * (UP_N / 32), I_WOUT = (D / 64) * (D / 32), I_RIN = (D / 64) * (RET_IN / 32), I_ROUT = (RET_MIX / 64) * (D / 32);
    constexpr int N_SMALL = 2 * (I_WIN + I_WUP + I_WOUT + I_RIN + I_ROUT);
    for (int it = gw; it < N_SMALL; it += NGW) {
        int r = it;
        {
            const int i = r & 1; r >>= 1;
            if (r < I_WIN) { const float* W = a.in[9] + (size_t)i * D * HY_IN; const int nblk = HY_LD / 32;
                tr_item([=](int n, int k) { return n < HY_IN ? W[(size_t)k * HY_IN + n] : 0.f; }, D, (bf16*)(ws + WS_WIN) + (size_t)i * HY_LD * D, 64 * (r / nblk), 32 * (r % nblk), scr, lane); continue; }
            r -= I_WIN;
            if (r < I_WUP) { const float* Wq = a.in[11] + (size_t)i * 256 * 768; const float* Wkv = a.in[13] + (size_t)i * 128 * 1024; const float* gq = a.in[10] + i * 256; const float* gkv = a.in[12] + i * 128; const int nblk = UP_N / 32;
                tr_item([=](int n, int k) { return n < 768 ? (k < 256 ? gq[k] * Wq[(size_t)k * 768 + n] : 0.f) : (k >= 256 ? gkv[k - 256] * Wkv[(size_t)(k - 256) * 1024 + (n - 768)] : 0.f); },
                        UP_K, (bf16*)(ws + WS_WUP) + (size_t)i * UP_N * UP_K, 64 * (r / nblk), 32 * (r % nblk), scr, lane); continue; }
            r -= I_WUP;
            if (r < I_WOUT) { const float* W = a.in[18] + (size_t)i * D * D; const int nblk = D / 32;
                tr_item([=](int n, int k) { return W[(size_t)k * D + n]; }, D, (bf16*)(ws + WS_WOUT) + (size_t)i * D * D, 64 * (r / nblk), 32 * (r % nblk), scr, lane); continue; }
            r -= I_WOUT;
            if (r < I_RIN) { const float* W = a.in[19] + (size_t)i * D * RET_IN; const int nblk = RET_IN / 32;
                tr_item([=](int n, int k) { const int nn = n < 2048 ? ((n & ~127) + ((n & 16) ? 64 : 0) + 16 * ((n & 127) >> 5) + (n & 15)) : n; return W[(size_t)k * RET_IN + nn]; }, D, (bf16*)(ws + WS_RIN) + (size_t)i * RET_IN * D, 64 * (r / nblk), 32 * (r % nblk), scr, lane); continue; }
            r -= I_RIN;
            { const float* W = a.in[22] + (size_t)i * RET_MIX * D; const int nblk = D / 32;
                tr_item([=](int n, int k) { return W[(size_t)k * D + n]; }, RET_MIX, (bf16*)(ws + WS_ROUT) + (size_t)i * D * RET_MIX, 64 * (r / nblk), 32 * (r % nblk), scr, lane); continue; }
        }
    }
}

constexpr int MOE_I_GU = (D / 64) * (1024 / 32), MOE_I_D = (FF / 64) * (D / 32), MOE_ITEMS_PER_LAYER = NE * (MOE_I_GU + MOE_I_D);
__device__ __forceinline__ void moe_item_load(const Args& a, int it, int lane, float (&tv)[32]) {
    const int layer = it / MOE_ITEMS_PER_LAYER; int r = it % MOE_ITEMS_PER_LAYER;
    if (r < NE * MOE_I_GU) { const int le = layer * NE + r / MOE_I_GU; r %= MOE_I_GU; const int k0 = 64 * (r / 32), n0 = 32 * (r % 32), G32 = n0 >> 5, t = lane & 31;
        const float* W = (t < 16 ? a.in[27] : a.in[28]) + (size_t)le * D * FF + 16 * G32 + (t & 15);
#pragma unroll
        for (int i = 0; i < 32; ++i) tv[i] = W[(size_t)(k0 + 2 * i + (lane >> 5)) * FF];
    } else { r -= NE * MOE_I_GU; const int le = layer * NE + r / MOE_I_D; r %= MOE_I_D; const int k0 = 64 * (r / 32), n0 = 32 * (r % 32);
        const float* W = a.in[29] + (size_t)le * FF * D + n0 + (lane & 31);
#pragma unroll
        for (int i = 0; i < 32; ++i) tv[i] = W[(size_t)(k0 + 2 * i + (lane >> 5)) * D];
    }
}
__device__ __forceinline__ void moe_item_store(const Args& a, int it, int lane, const float (&tv)[32], LAS float* scr) {
    const int layer = it / MOE_ITEMS_PER_LAYER; int r = it % MOE_ITEMS_PER_LAYER; bf16* WT; int K, k0, n0;
    if (r < NE * MOE_I_GU) { const int le = layer * NE + r / MOE_I_GU; r %= MOE_I_GU; K = D; WT = (bf16*)(a.ws + WS_WGU) + (size_t)le * 1024 * D; k0 = 64 * (r / 32); n0 = 32 * (r % 32); }
    else { r -= NE * MOE_I_GU; const int le = layer * NE + r / MOE_I_D; r %= MOE_I_D; K = FF; WT = (bf16*)(a.ws + WS_WD) + (size_t)le * D * FF; k0 = 64 * (r / 32); n0 = 32 * (r % 32); }
#pragma unroll
    for (int i = 0; i < 32; ++i) { const int kk = 2 * i + (lane >> 5); scr[kk * 33 + (lane & 31)] = tv[i]; }
    LDS_WAIT(); asm volatile("" ::: "memory");
    const int c = lane & 7;
#pragma unroll
    for (int j = 0; j < 4; ++j) { const int n = (lane >> 3) + 8 * j; const LAS float* s = scr + (8 * c) * 33 + n;
        v4u o; o.x = pk2(s[0 * 33], s[1 * 33]); o.y = pk2(s[2 * 33], s[3 * 33]); o.z = pk2(s[4 * 33], s[5 * 33]); o.w = pk2(s[6 * 33], s[7 * 33]);
        *(GAS v4u*)(WT + (size_t)(n0 + n) * K + k0 + 8 * c) = o; }
    LDS_WAIT(); asm volatile("" ::: "memory");
}
__device__ __forceinline__ void moe_convert(const Args& a, LAS float* scr, int lane, int it_lo, int it_hi, int worker, int n_workers) {
    int it = it_lo + worker;
    if (it >= it_hi) return;
    float cur[32], nxt[32];
    moe_item_load(a, it, lane, cur);
    for (; it < it_hi; it += n_workers) {
        const bool more = it + n_workers < it_hi;
        if (more) moe_item_load(a, it + n_workers, lane, nxt);
        moe_item_store(a, it, lane, cur, scr);
        if (more) {
#pragma unroll
            for (int i = 0; i < 32; ++i) cur[i] = nxt[i];
        }
    }
}
typedef short s16x4 __attribute__((ext_vector_type(4)));
typedef short v4i16_t __attribute__((ext_vector_type(4)));
__device__ __forceinline__ s16x4 lds_tr16(const LAS unsigned char* p) { return __builtin_bit_cast(s16x4, __builtin_amdgcn_ds_read_tr16_b64_v4i16((LAS v4i16_t*)p)); }
__device__ __forceinline__ f32x4 mfma16(bf16x8 a, bf16x8 b, f32x4 c) { return __builtin_amdgcn_mfma_f32_16x16x32_bf16(a, b, c, 0, 0, 0); }
__device__ __forceinline__ bf16x8 cat4(s16x4 a, s16x4 b) { return __builtin_shufflevector(a, b, 0, 1, 2, 3, 4, 5, 6, 7); }
__device__ __forceinline__ unsigned cvtpk(float lo, float hi) { typedef float f2_t __attribute__((ext_vector_type(2))); typedef __bf16 b2_t __attribute__((ext_vector_type(2))); f2_t v = {lo, hi}; b2_t b = __builtin_convertvector(v, b2_t); return __builtin_bit_cast(unsigned, b); }
__device__ __forceinline__ bf16x8 pack8(f32x4 a, f32x4 b) { v4u w; w.x = cvtpk(a[0], a[1]); w.y = cvtpk(a[2], a[3]); w.z = cvtpk(b[0], b[1]); w.w = cvtpk(b[2], b[3]); return __builtin_bit_cast(bf16x8, w); }

__device__ __forceinline__ float bflo(unsigned x) { return __uint_as_float(x << 16); }
__device__ __forceinline__ float bfhi(unsigned x) { return __uint_as_float(x & 0xffff0000u); }
constexpr int AT_KSTR = 208, AT_VSTR = 144, AT_KBUF = 64 * AT_KSTR, AT_VBUF = 64 * AT_VSTR;
__device__ __forceinline__ void attn_unit(Frame& F, const bf16* __restrict__ quk, const bf16* __restrict__ Kr, bf16* __restrict__ mix, int b, int h, int qb) {
    LAS unsigned char* Kb = F.lds + RING_OFF; LAS unsigned char* Vb = F.lds + RING_OFF + 2 * AT_KBUF;
    int tid_ = threadIdx.x; asm volatile("" : "+v"(tid_));
    const int tid = tid_, lane = tid & 63, w = __builtin_amdgcn_readfirstlane(tid >> 6), g = lane >> 4, c16 = lane & 15;
    const int q0 = qb * 128 + 16 * w;
    const size_t tb = (size_t)b * SEQ;
    bf16x8 qf[3];
    { const bf16* qp = quk + (tb + q0 + c16) * UP_N + h * 96 + 8 * g;
#pragma unroll
      for (int ks = 0; ks < 3; ++ks) qf[ks] = *(const bf16x8*)(qp + 32 * ks); }
    f32x4 O[4];
#pragma unroll
    for (int mt = 0; mt < 4; ++mt) O[mt] = (f32x4){0.f, 0.f, 0.f, 0.f};
    float m = -1e30f, l = 0.f;
    const int nkt = 2 * qb + 2;
    const int krow = tid >> 3, kc = tid & 7, rrow = (tid >> 2) & 63, rc = tid & 3;
    const bf16* gK = quk + (tb + krow) * UP_N + 768 + h * 128 + kc * 8;
    const bf16* gR = Kr + (tb + rrow) * 32 + rc * 8;
    v4u rk = *(const v4u*)gK, rv = *(const v4u*)(gK + 64), rr = *(const v4u*)gR;
    const int aoffK = c16 * AT_KSTR + 16 * g;
    const int aoffV = (4 * g + (c16 >> 2)) * AT_VSTR + 8 * (lane & 3);
    for (int kt = 0; kt < nkt; ++kt) {
        LAS unsigned char* Kc = Kb + (kt & 1) * AT_KBUF; LAS unsigned char* Vc = Vb + (kt & 1) * AT_VBUF;
        *(LAS v4u*)(Kc + krow * AT_KSTR + kc * 16) = rk; *(LAS v4u*)(Vc + krow * AT_VSTR + kc * 16) = rv;
        if (tid < 256) *(LAS v4u*)(Kc + rrow * AT_KSTR + 128 + rc * 16) = rr;
        __syncthreads();
        if (kt + 1 < nkt) { const size_t off = (size_t)(kt + 1) * 64; rk = *(const v4u*)(gK + off * UP_N); rv = *(const v4u*)(gK + off * UP_N + 64); rr = *(const v4u*)(gR + off * 32); }
        const int k0 = kt * 64;
        if (k0 <= q0 + 15) {
            f32x4 S[4];
#pragma unroll
            for (int mt = 0; mt < 4; ++mt) { S[mt] = (f32x4){0.f, 0.f, 0.f, 0.f};
#pragma unroll
                for (int ks = 0; ks < 3; ++ks) { const bf16x8 a = *(const LAS bf16x8*)(Kc + aoffK + mt * 16 * AT_KSTR + ks * 64); S[mt] = mfma16(a, qf[ks], S[mt]); } }
            if (k0 + 63 > q0) {
                const int q = q0 + c16;
#pragma unroll
                for (int mt = 0; mt < 4; ++mt)
#pragma unroll
                    for (int r = 0; r < 4; ++r) if (k0 + 16 * mt + 4 * g + r > q) S[mt][r] = -1e30f;
            }
            float mx = fmaxf(fmaxf(S[0][0], S[0][1]), fmaxf(S[0][2], S[0][3]));
#pragma unroll
            for (int mt = 1; mt < 4; ++mt) mx = fmaxf(mx, fmaxf(fmaxf(S[mt][0], S[mt][1]), fmaxf(S[mt][2], S[mt][3])));
            mx = fmaxf(mx, __shfl_xor(mx, 16)); mx = fmaxf(mx, __shfl_xor(mx, 32));
            const float mn = fmaxf(m, mx), alpha = __builtin_amdgcn_exp2f(m - mn); m = mn;
            float ls = 0.f;
#pragma unroll
            for (int mt = 0; mt < 4; ++mt)
#pragma unroll
                for (int r = 0; r < 4; ++r) { S[mt][r] = __builtin_amdgcn_exp2f(S[mt][r] - mn); ls += S[mt][r]; }
            l = l * alpha + ls;
#pragma unroll
            for (int mt = 0; mt < 4; ++mt) O[mt] = O[mt] * alpha;
            bf16x8 pf[2]; pf[0] = pack8(S[0], S[1]); pf[1] = pack8(S[2], S[3]);
#pragma unroll
            for (int mt = 0; mt < 4; ++mt)
#pragma unroll
                for (int s = 0; s < 2; ++s) {
                    const s16x4 v0 = lds_tr16(Vc + aoffV + (32 * s) * AT_VSTR + mt * 32), v1 = lds_tr16(Vc + aoffV + (32 * s + 16) * AT_VSTR + mt * 32);
                    O[mt] = mfma16(cat4(v0, v1), pf[s], O[mt]);
                }
        }
    }
    l += __shfl_xor(l, 16); l += __shfl_xor(l, 32);
    const float inv = 1.f / l;
    bf16* op = mix + (tb + q0 + c16) * 1024 + h * 64 + 4 * g;
#pragma unroll
    for (int mt = 0; mt < 4; ++mt) { const f32x4 o = O[mt] * inv; typedef unsigned u2_t __attribute__((ext_vector_type(2))); u2_t wv; wv.x = cvtpk(o[0], o[1]); wv.y = cvtpk(o[2], o[3]); *(u2_t*)(op + 16 * mt) = wv; }
    __syncthreads();
}
__device__ __forceinline__ void attn_phase(Frame& F, const bf16* quk, const bf16* Kr, bf16* mix) {
    for (int u = F.vcu; u < 512; u += F.G) {
        const int bh = u >> 4, p = u & 15;
        for (int j = 0; j < 2; ++j) attn_unit(F, quk, Kr, mix, bh >> 3, bh & 7, j ? p : 31 - p);
    }
}
typedef float f32x16 __attribute__((ext_vector_type(16)));
__device__ __forceinline__ f32x16 mfma32(bf16x8 a, bf16x8 b, f32x16 c) { return __builtin_amdgcn_mfma_f32_32x32x16_bf16(a, b, c, 0, 0, 0); }
#define LDS_BARRIER() do { asm volatile("s_waitcnt lgkmcnt(0)" ::: "memory"); __builtin_amdgcn_s_barrier(); asm volatile("" ::: "memory"); } while (0)
constexpr int A2_KSTR = 208, A2_VSTR = 144, A2_KBUF = 128 * A2_KSTR, A2_VBUF = 128 * A2_VSTR;
__device__ __forceinline__ void attn2_unit(Frame& F, const bf16* __restrict__ quk, const bf16* __restrict__ Kr, bf16* __restrict__ mix, int b, int h, int qb) {
    int tid_ = threadIdx.x; asm volatile("" : "+v"(tid_));
    const int tid = tid_, lane = tid & 63, w = __builtin_amdgcn_readfirstlane(tid >> 6), r = lane & 31, hh = lane >> 5;
    LAS unsigned char* Kb = F.lds + RING_OFF; LAS unsigned char* Vb = F.lds + RING_OFF + 2 * A2_KBUF;
    const int q0 = qb * 256 + 32 * w;
    const size_t tb = (size_t)b * SEQ;
    bf16x8 qf[6];
    { const bf16* qp = quk + (tb + q0 + r) * UP_N + h * 96 + 8 * hh;
#pragma unroll
      for (int ks = 0; ks < 6; ++ks) qf[ks] = *(const bf16x8*)(qp + 16 * ks); }
    f32x16 O[2];
#pragma unroll
    for (int i = 0; i < 16; ++i) { O[0][i] = 0.f; O[1][i] = 0.f; }
    float m = -1e30f, l = 0.f;
    const int nkt = 2 * qb + 2;
    const int krow = tid >> 3, kc = tid & 7, rrow = tid >> 2, rc = tid & 3;
    const bf16* gK = quk + (tb + krow) * UP_N + 768 + h * 128 + kc * 8;
    const bf16* gR = Kr + (tb + rrow) * 32 + rc * 8;
    v4u rk0 = *(const v4u*)gK, rk1 = *(const v4u*)(gK + (size_t)64 * UP_N), rv0 = *(const v4u*)(gK + 64), rv1 = *(const v4u*)(gK + (size_t)64 * UP_N + 64), rr = *(const v4u*)gR;
    v4u nk0 = rk0, nk1 = rk1, nv0 = rv0, nv1 = rv1, nr = rr;
    if (nkt > 1) { const size_t off = 128; nk0 = *(const v4u*)(gK + off * UP_N); nk1 = *(const v4u*)(gK + (off + 64) * UP_N); nv0 = *(const v4u*)(gK + off * UP_N + 64); nv1 = *(const v4u*)(gK + (off + 64) * UP_N + 64); nr = *(const v4u*)(gR + off * 32); }
    const int aoffK = r * A2_KSTR + 16 * hh;
    const int aoffV = (4 * hh + ((lane & 15) >> 2)) * A2_VSTR + (16 * ((lane >> 4) & 1) + 4 * (lane & 3)) * 2;
    for (int kt = 0; kt < nkt; ++kt) {
        LAS unsigned char* Kc = Kb + (kt & 1) * A2_KBUF; LAS unsigned char* Vc = Vb + (kt & 1) * A2_VBUF;
        *(LAS v4u*)(Kc + krow * A2_KSTR + kc * 16) = rk0; *(LAS v4u*)(Kc + (krow + 64) * A2_KSTR + kc * 16) = rk1;
        *(LAS v4u*)(Vc + krow * A2_VSTR + kc * 16) = rv0; *(LAS v4u*)(Vc + (krow + 64) * A2_VSTR + kc * 16) = rv1;
        *(LAS v4u*)(Kc + rrow * A2_KSTR + 128 + rc * 16) = rr;
        LDS_BARRIER();
        rk0 = nk0; rk1 = nk1; rv0 = nv0; rv1 = nv1; rr = nr;
        if (kt + 2 < nkt) { const size_t off = (size_t)(kt + 2) * 128;
            nk0 = *(const v4u*)(gK + off * UP_N); nk1 = *(const v4u*)(gK + (off + 64) * UP_N); nv0 = *(const v4u*)(gK + off * UP_N + 64); nv1 = *(const v4u*)(gK + (off + 64) * UP_N + 64); nr = *(const v4u*)(gR + off * 32); }
        const int k0 = kt * 128;
        int nkb = ((q0 - k0) >> 5) + 1; nkb = nkb > 4 ? 4 : nkb;
        if (nkb > 0) {
            f32x16 S[4];
            bf16x8 kf[2][6];
#pragma unroll
            for (int ks = 0; ks < 6; ++ks) kf[0][ks] = *(const LAS bf16x8*)(Kc + aoffK + ks * 32);
#pragma unroll
            for (int kb = 0; kb < 4; ++kb) {
                if (kb < nkb) {
                    if (kb + 1 < 4 && kb + 1 < nkb) {
#pragma unroll
                        for (int ks = 0; ks < 6; ++ks) kf[(kb + 1) & 1][ks] = *(const LAS bf16x8*)(Kc + aoffK + (kb + 1) * 32 * A2_KSTR + ks * 32);
                    }
                    __builtin_amdgcn_sched_barrier(0);
#pragma unroll
                    for (int i = 0; i < 16; ++i) S[kb][i] = 0.f;
#pragma unroll
                    for (int ks = 0; ks < 6; ++ks) S[kb] = mfma32(kf[kb & 1][ks], qf[ks], S[kb]);
                    __builtin_amdgcn_sched_barrier(0);
                    if (k0 + 32 * kb == q0) {
#pragma unroll
                        for (int i = 0; i < 16; ++i) if ((i & 3) + 8 * (i >> 2) + 4 * hh > r) S[kb][i] = -1e30f;
                    }
                } else {
#pragma unroll
                    for (int i = 0; i < 16; ++i) S[kb][i] = -1e30f;
                }
            }
            float mx = -1e30f;
#pragma unroll
            for (int kb = 0; kb < 4; ++kb)
#pragma unroll
                for (int i = 0; i < 16; i += 2) mx = fmaxf(mx, fmaxf(S[kb][i], S[kb][i + 1]));
            mx = fmaxf(mx, __shfl_xor(mx, 32));
            const float mn = fmaxf(m, mx), alpha = __builtin_amdgcn_exp2f(m - mn); m = mn;
            float ls = 0.f;
#pragma unroll
            for (int kb = 0; kb < 4; ++kb)
#pragma unroll
                for (int i = 0; i < 16; ++i) { S[kb][i] = __builtin_amdgcn_exp2f(S[kb][i] - mn); ls += S[kb][i]; }
            l = l * alpha + ls;
            if (__any(alpha != 1.f)) {
#pragma unroll
                for (int i = 0; i < 16; ++i) { O[0][i] *= alpha; O[1][i] *= alpha; }
            }
#pragma unroll
            for (int kb = 0; kb < 4; ++kb) {
                if (kb < nkb) {
                    bf16x8 vf[2][2], pf[2];
#pragma unroll
                    for (int s = 0; s < 2; ++s)
#pragma unroll
                        for (int dvb = 0; dvb < 2; ++dvb) { const LAS unsigned char* vp = Vc + aoffV + (32 * kb + 16 * s) * A2_VSTR + dvb * 64; vf[s][dvb] = cat4(lds_tr16(vp), lds_tr16(vp + 8 * A2_VSTR)); }
#pragma unroll
                    for (int s = 0; s < 2; ++s) { v4u pw;
#pragma unroll
                        for (int e = 0; e < 4; ++e) pw[e] = cvtpk(S[kb][8 * s + 2 * e], S[kb][8 * s + 2 * e + 1]);
                        pf[s] = __builtin_bit_cast(bf16x8, pw); }
                    __builtin_amdgcn_sched_barrier(0);
#pragma unroll
                    for (int s = 0; s < 2; ++s)
#pragma unroll
                        for (int dvb = 0; dvb < 2; ++dvb) O[dvb] = mfma32(vf[s][dvb], pf[s], O[dvb]);
                    __builtin_amdgcn_sched_barrier(0);
                }
            }
        }
    }
    l += __shfl_xor(l, 32);
    const float inv = 1.f / l;
    bf16* op = mix + (tb + q0 + r) * 1024 + h * 64 + 4 * hh;
#pragma unroll
    for (int dvb = 0; dvb < 2; ++dvb)
#pragma unroll
        for (int gq = 0; gq < 4; ++gq) { typedef unsigned u2_t __attribute__((ext_vector_type(2))); u2_t wv;
            wv.x = cvtpk(O[dvb][4 * gq] * inv, O[dvb][4 * gq + 1] * inv); wv.y = cvtpk(O[dvb][4 * gq + 2] * inv, O[dvb][4 * gq + 3] * inv);
            *(u2_t*)(op + 32 * dvb + 8 * gq) = wv; }
    __syncthreads();
}
__device__ __forceinline__ float wave_sum(float v) {
#pragma unroll
    for (int o = 1; o < 64; o <<= 1) v += __shfl_xor(v, o);
    return v;
}
__device__ __forceinline__ void p0_extras(Frame& F, const Args& a) {
    int tid_ = threadIdx.x; asm volatile("" : "+v"(tid_));
    const int tid = tid_;
    __syncthreads();
    unsigned char* ws = a.ws;
    const int gt = (int)blockIdx.x * (NWAVES * 64) + tid, NT = F.G * NWAVES * 64;
    {
        const float* c = a.in[1]; const float* ada_w = a.in[3]; const float* ada_b = a.in[4]; float* mod = (float*)(ws + WS_MOD);
        LAS float* sc = (LAS float*)(F.lds + RING_OFF); LAS float* red = sc + NB * D;
        for (int i = tid; i < NB * D; i += NWAVES * 64) sc[i] = silu_f(c[i]);
        __syncthreads();
        const int nl = tid & 127, kq = tid >> 7;
        for (int it = (int)blockIdx.x; it < DEPTH * 6 * D / 128; it += F.G) {
            const int col = it * 128 + nl, l = col / (6 * D), n = col % (6 * D);
            const float* w = ada_w + (size_t)l * D * 6 * D + n + (size_t)(kq * 256) * 6 * D;
            float acc0 = 0.f, acc1 = 0.f, acc2 = 0.f, acc3 = 0.f;
#pragma unroll 16
            for (int k = 0; k < 256; ++k) {
                const float wv = w[(size_t)k * 6 * D]; const int kk = kq * 256 + k;
                acc0 += sc[kk] * wv; acc1 += sc[D + kk] * wv; acc2 += sc[2 * D + kk] * wv; acc3 += sc[3 * D + kk] * wv;
            }
            red[(kq * 4 + 0) * 128 + nl] = acc0; red[(kq * 4 + 1) * 128 + nl] = acc1; red[(kq * 4 + 2) * 128 + nl] = acc2; red[(kq * 4 + 3) * 128 + nl] = acc3;
            __syncthreads();
            { const int b = kq;
              const float v = (red[(0 * 4 + b) * 128 + nl] + red[(1 * 4 + b) * 128 + nl]) + (red[(2 * 4 + b) * 128 + nl] + red[(3 * 4 + b) * 128 + nl]);
              mod[((size_t)l * NB + b) * 6 * D + n] = v + ada_b[l * 6 * D + n]; }
            __syncthreads();
        }
        __syncthreads();
    }
    {
        const int* positions = (const int*)a.in[2]; float* csm = (float*)(ws + WS_CSM); float* csr = (float*)(ws + WS_CSR);
        for (int idx = gt; idx < T * 80; idx += NT) {
            const int t = idx / 80, j = idx % 80; const float pos = (float)positions[t];
            if (j < 16) { const float ang = pos * powf(10000.f, -(float)(2 * j) / 32.f); csm[((size_t)t * 16 + j) * 2] = cosf(ang); csm[((size_t)t * 16 + j) * 2 + 1] = sinf(ang); }
            else { const int i = j - 16; const float ang = pos * powf(10000.f, -(float)(2 * i) / 128.f); csr[((size_t)t * 64 + i) * 2] = cosf(ang); csr[((size_t)t * 64 + i) * 2 + 1] = sinf(ang); }
        }
    }
}
__device__ __forceinline__ void init_mod_phase(Frame& F, const float* __restrict__ x_in, float* __restrict__ x, const float* __restrict__ mod_l, bf16* __restrict__ hb) {
    int tid_ = threadIdx.x; asm volatile("" : "+v"(tid_));
    const int lane = tid_ & 63, gw = (int)blockIdx.x * NWAVES + (tid_ >> 6), NGW = F.G * NWAVES;
    for (int t = gw; t < T; t += NGW) {
        const float* m = mod_l + (size_t)(t / SEQ) * 6 * D;
#pragma unroll
        for (int j = 0; j < 4; ++j) {
            const int d = 4 * lane + 256 * j;
            const f32x4 v = *(const f32x4*)(x_in + (size_t)t * D + d), sh = *(const f32x4*)(m + d), sc = *(const f32x4*)(m + D + d);
            *(f32x4*)(x + (size_t)t * D + d) = v;
            const f32x4 hv = v * (1.f + sc) + sh;
            typedef unsigned u2_t __attribute__((ext_vector_type(2))); u2_t o; o.x = cvtpk(hv[0], hv[1]); o.y = cvtpk(hv[2], hv[3]);
            *(u2_t*)(hb + (size_t)t * D + d) = o;
        }
    }
}
__device__ __forceinline__ void mla_prep_phase(Frame& F, const bf16* __restrict__ projb, const float* __restrict__ csm, bf16* __restrict__ upA, bf16* __restrict__ Kr) {
    int tid_ = threadIdx.x; asm volatile("" : "+v"(tid_));
    const int lane = tid_ & 63, gw = (int)blockIdx.x * NWAVES + (tid_ >> 6), NGW = F.G * NWAVES;
    typedef unsigned u2_t __attribute__((ext_vector_type(2)));
    for (int t = gw; t < T; t += NGW) {
        const bf16* p = projb + (size_t)t * HY_LD;
        const u2_t qv = *(const u2_t*)(p + 4 * lane); const unsigned kv = *(const unsigned*)(p + 256 + 2 * lane);
        const float q0 = bflo(qv.x), q1 = bfhi(qv.x), q2 = bflo(qv.y), q3 = bfhi(qv.y), k0 = bflo(kv), k1 = bfhi(kv);
        const float rq = rsqrtf(wave_sum((q0 * q0 + q1 * q1) + (q2 * q2 + q3 * q3)) * (1.f / 256.f) + RMS_EPS);
        const float rk = rsqrtf(wave_sum(k0 * k0 + k1 * k1) * (1.f / 128.f) + RMS_EPS);
        u2_t o; o.x = cvtpk(q0 * rq, q1 * rq); o.y = cvtpk(q2 * rq, q3 * rq);
        *(u2_t*)(upA + (size_t)t * UP_K + 4 * lane) = o;
        *(unsigned*)(upA + (size_t)t * UP_K + 256 + 2 * lane) = cvtpk(k0 * rk, k1 * rk);
        if (lane < 16) {
            const float x1 = bf2f(p[384 + lane]), x2 = bf2f(p[400 + lane]);
            const float c = csm[((size_t)t * 16 + lane) * 2], s = csm[((size_t)t * 16 + lane) * 2 + 1];
            Kr[(size_t)t * 32 + lane] = f2b(x1 * c - x2 * s); Kr[(size_t)t * 32 + 16 + lane] = f2b(x1 * s + x2 * c);
        }
    }
}
__device__ __forceinline__ void ln_row(f32x4 (&v)[4], const float* __restrict__ g, const float* __restrict__ bta, int lane) {
    float s = 0.f;
#pragma unroll
    for (int j = 0; j < 4; ++j) s += (v[j][0] + v[j][1]) + (v[j][2] + v[j][3]);
    const float mean = wave_sum(s) * (1.f / D); float q = 0.f;
#pragma unroll
    for (int j = 0; j < 4; ++j) { v[j] = v[j] - mean; q += (v[j][0] * v[j][0] + v[j][1] * v[j][1]) + (v[j][2] * v[j][2] + v[j][3] * v[j][3]); }
    const float rstd = rsqrtf(wave_sum(q) * (1.f / D) + LN_EPS);
#pragma unroll
    for (int j = 0; j < 4; ++j) { const int d = 4 * lane + 256 * j; v[j] = v[j] * rstd * *(const f32x4*)(g + d) + *(const f32x4*)(bta + d); }
}
constexpr int LR_HSTR = 1028, LR_H = 0, LR_PART = 16 * LR_HSTR * 4, LR_LOG = LR_PART + 8 * 16 * 48 * 4, LR_CNT = LR_LOG + 16 * 48 * 4, LR_SLOT = LR_CNT + 256;
__device__ __forceinline__ void ln_router_phase(Frame& F, const float* x, float* xo, const float* __restrict__ y, const float* __restrict__ mod_l, const float* __restrict__ lg, const float* __restrict__ lb,
                                                const float* __restrict__ wgrp, const float* __restrict__ bgrp, const float* __restrict__ wexp, const float* __restrict__ bexp,
                                                bf16* __restrict__ hb, int* __restrict__ slot_e, float* __restrict__ slot_w, int* __restrict__ slot_pos, int* __restrict__ gcnt, int* __restrict__ tok_of) {
    int tid_ = threadIdx.x; asm volatile("" : "+v"(tid_));
    const int tid = tid_, lane = tid & 63, w = __builtin_amdgcn_readfirstlane(tid >> 6), g = lane >> 4, c16 = lane & 15;
    LAS float* hT = (LAS float*)(F.lds + RING_OFF + LR_H); LAS float* part = (LAS float*)(F.lds + RING_OFF + LR_PART); LAS float* logit = (LAS float*)(F.lds + RING_OFF + LR_LOG);
    LAS int* lcnt = (LAS int*)(F.lds + RING_OFF + LR_CNT); LAS int* lbase = lcnt + 32; LAS int* sl_e = (LAS int*)(F.lds + RING_OFF + LR_SLOT); LAS int* sl_p = sl_e + 128; LAS float* sl_w = (LAS float*)(sl_p + 128);
    typedef unsigned u2_t __attribute__((ext_vector_type(2)));
    float rw0[8][4], rw1[8][4], rw2[8][4];
#pragma unroll
    for (int kk = 0; kk < 8; ++kk)
#pragma unroll
        for (int tt = 0; tt < 4; ++tt) { const int k = 128 * w + 16 * kk + 4 * g + tt;
            rw0[kk][tt] = wexp[k * NE + c16]; rw1[kk][tt] = wexp[k * NE + 16 + c16]; rw2[kk][tt] = (c16 < NG) ? wgrp[k * NG + c16] : 0.f; }
    for (int blk = (int)blockIdx.x; blk < T / 64; blk += F.G) {
        const int r0 = blk * 64;
        if (tid < 32) lcnt[tid] = 0;
        for (int tI = 0; tI < 4; ++tI) {
#pragma unroll 1
            for (int rr = 0; rr < 2; ++rr) {
                const int lr = 2 * w + rr, t = r0 + 16 * tI + lr;
                const float* m = mod_l + (size_t)(t / SEQ) * 6 * D;
                f32x4 v[4];
#pragma unroll
                for (int j = 0; j < 4; ++j) { const int d = 4 * lane + 256 * j; v[j] = ALPHA * *(const f32x4*)(x + (size_t)t * D + d) + (1.f + *(const f32x4*)(m + 2 * D + d)) * *(const f32x4*)(y + (size_t)t * D + d); }
                ln_row(v, lg, lb, lane);
#pragma unroll
                for (int j = 0; j < 4; ++j) { const int d = 4 * lane + 256 * j;
                    *(f32x4*)(xo + (size_t)t * D + d) = v[j];
                    const f32x4 hv = v[j] * (1.f + *(const f32x4*)(m + 4 * D + d)) + *(const f32x4*)(m + 3 * D + d);
                    u2_t o; o.x = cvtpk(hv[0], hv[1]); o.y = cvtpk(hv[2], hv[3]); *(u2_t*)(hb + (size_t)t * D + d) = o;
                    *(LAS f32x4*)(hT + lr * LR_HSTR + d) = hv; }
            }
            __syncthreads();
            {
                f32x4 acc[3]; acc[0] = (f32x4){0.f, 0.f, 0.f, 0.f}; acc[1] = acc[0]; acc[2] = acc[0];
#pragma unroll
                for (int kk = 0; kk < 8; ++kk) {
                    const int kb = 128 * w + 16 * kk + 4 * g;
                    const f32x4 a4 = *(const LAS f32x4*)(hT + c16 * LR_HSTR + kb);
#pragma unroll
                    for (int tt = 0; tt < 4; ++tt) {
                        acc[0] = __builtin_amdgcn_mfma_f32_16x16x4f32(a4[tt], rw0[kk][tt], acc[0], 0, 0, 0);
                        acc[1] = __builtin_amdgcn_mfma_f32_16x16x4f32(a4[tt], rw1[kk][tt], acc[1], 0, 0, 0);
                        acc[2] = __builtin_amdgcn_mfma_f32_16x16x4f32(a4[tt], rw2[kk][tt], acc[2], 0, 0, 0);
                    }
                }
#pragma unroll
                for (int nt = 0; nt < 3; ++nt)
#pragma unroll
                    for (int r = 0; r < 4; ++r) part[(w * 16 + 4 * g + r) * 48 + 16 * nt + c16] = acc[nt][r];
            }
            __syncthreads();
            for (int o = tid; o < 16 * 36; o += NWAVES * 64) {
                const int row = o / 36, col = o % 36;
                float s = 0.f;
#pragma unroll
                for (int ww = 0; ww < 8; ++ww) s += part[(ww * 16 + row) * 48 + col];
                logit[row * 48 + col] = s + (col < 32 ? bexp[col] : bgrp[col - 32]);
            }
            __syncthreads();
            if (tid < 16) {
                const LAS float* lr = logit + tid * 48;
                int gi = 0; float gbest = lr[32];
#pragma unroll
                for (int j = 1; j < 4; ++j) { const float vv = lr[32 + j]; if (vv > gbest) { gbest = vv; gi = j; } }
                float den = 0.f;
#pragma unroll
                for (int j = 0; j < 4; ++j) den += expf(lr[32 + j] - gbest);
                const float gtop = 1.f / den;
                int i0 = 0; float b0 = lr[gi * 8];
#pragma unroll
                for (int j = 1; j < 8; ++j) { const float vv = lr[gi * 8 + j]; if (vv > b0) { b0 = vv; i0 = j; } }
                int i1 = -1; float b1 = -3.4e38f;
#pragma unroll
                for (int j = 0; j < 8; ++j) { const float vv = lr[gi * 8 + j]; if (j != i0 && vv > b1) { b1 = vv; i1 = j; } }
                const float e1 = expf(b1 - b0);
                const int ex0 = gi * 8 + i0, ex1 = gi * 8 + i1, sidx = (16 * tI + tid) * 2;
                sl_e[sidx] = ex0; sl_e[sidx + 1] = ex1; sl_w[sidx] = gtop / (1.f + e1); sl_w[sidx + 1] = gtop * e1 / (1.f + e1);
                sl_p[sidx] = __hip_atomic_fetch_add(&lcnt[ex0], 1, __ATOMIC_RELAXED, __HIP_MEMORY_SCOPE_WORKGROUP); sl_p[sidx + 1] = __hip_atomic_fetch_add(&lcnt[ex1], 1, __ATOMIC_RELAXED, __HIP_MEMORY_SCOPE_WORKGROUP);
            }
            __syncthreads();
        }
        if (tid < 32) lbase[tid] = atomicAdd(&gcnt[tid], lcnt[tid]);
        __syncthreads();
        if (tid < 128) { const int gs = r0 * 2 + tid, e = sl_e[tid]; slot_e[gs] = e; slot_w[gs] = sl_w[tid]; const int pos = lbase[e] + sl_p[tid]; slot_pos[gs] = pos; tok_of[e * 16384 + pos] = r0 + (tid >> 1); }
        __syncthreads();
    }
}
__device__ __forceinline__ int moe_tables(Frame& F, const int* __restrict__ gcnt) {
    LAS int* tab = (LAS int*)(F.lds + MOE_TAB_OFF);
    int tid_ = threadIdx.x; asm volatile("" : "+v"(tid_));
    __syncthreads();
    if (tid_ < 64) {
        const int e = tid_ & 31; const int c = gcnt[e], nt = (c + 255) >> 8;
        int incl = nt;
#pragma unroll
        for (int o = 1; o < 32; o <<= 1) { const int t = __shfl_up(incl, o, 32); if (e >= o) incl += t; }
        if (tid_ < 32) { tab[e] = incl - nt; tab[256 + e] = c; if (e == 31) tab[32] = incl; for (int rt = incl - nt; rt < incl; ++rt) tab[64 + rt] = e; }
    }
    __syncthreads();
    return tab[32];
}
__device__ __forceinline__ void ln_ffn_phase(Frame& F, const float* x, float* xo, const bf16* __restrict__ Yp, const int* __restrict__ slot_e, const int* __restrict__ slot_pos, const int* __restrict__ gcnt, const float* __restrict__ slot_w, const float* __restrict__ mod_l,
                                             const float* __restrict__ lg, const float* __restrict__ lb, const float* __restrict__ mod_next, bf16* __restrict__ hb) {
    int tid_ = threadIdx.x; asm volatile("" : "+v"(tid_));
    const int lane = tid_ & 63, gw = (int)blockIdx.x * NWAVES + (tid_ >> 6), NGW = F.G * NWAVES;
    typedef unsigned u2_t __attribute__((ext_vector_type(2)));
    moe_tables(F, gcnt);
    const LAS int* tab = (const LAS int*)(F.lds + MOE_TAB_OFF);
    for (int t0 = gw; t0 < T; t0 += 2 * NGW) {
        f32x4 v[2][4];
#pragma unroll
        for (int rr = 0; rr < 2; ++rr) {
            const int t = t0 + rr * NGW;
            const float* m = mod_l + (size_t)(t / SEQ) * 6 * D;
            const float w0 = slot_w[2 * t], w1 = slot_w[2 * t + 1];
            const bf16* y0 = Yp + (size_t)(tab[slot_e[2 * t]] * 256 + slot_pos[2 * t]) * D; const bf16* y1 = Yp + (size_t)(tab[slot_e[2 * t + 1]] * 256 + slot_pos[2 * t + 1]) * D;
#pragma unroll
            for (int j = 0; j < 4; ++j) { const int d = 4 * lane + 256 * j;
                const u2_t a = *(const u2_t*)(y0 + d), bq = *(const u2_t*)(y1 + d);
                const f32x4 ya = {bflo(a.x), bfhi(a.x), bflo(a.y), bfhi(a.y)}, yb = {bflo(bq.x), bfhi(bq.x), bflo(bq.y), bfhi(bq.y)};
                const f32x4 yy = w0 * ya + w1 * yb;
                v[rr][j] = ALPHA * *(const f32x4*)(x + (size_t)t * D + d) + (1.f + *(const f32x4*)(m + 5 * D + d)) * yy; }
        }
#pragma unroll
        for (int rr = 0; rr < 2; ++rr) {
            const int t = t0 + rr * NGW;
            ln_row(v[rr], lg, lb, lane);
#pragma unroll
            for (int j = 0; j < 4; ++j) { const int d = 4 * lane + 256 * j;
                *(f32x4*)(xo + (size_t)t * D + d) = v[rr][j];
                if (mod_next) { const float* mn = mod_next + (size_t)(t / SEQ) * 6 * D;
                    const f32x4 hv = v[rr][j] * (1.f + *(const f32x4*)(mn + D + d)) + *(const f32x4*)(mn + d);
                    u2_t o; o.x = cvtpk(hv[0], hv[1]); o.y = cvtpk(hv[2], hv[3]); *(u2_t*)(hb + (size_t)t * D + d) = o; }
            }
        }
    }
}
constexpr int RT_STR = 272, RT_TILE = 128 * RT_STR, RT_VSTR = 80, RT_VTILE = 128 * RT_VSTR;
__device__ __forceinline__ float ret_log2gamma(int h) { return log2f(1.f - exp2f(-5.f - (float)h)); }

__device__ __forceinline__ void ret_state_phase(Frame& F, const bf16* __restrict__ projb, bf16* __restrict__ ST) {
    int tid_ = threadIdx.x; asm volatile("" : "+v"(tid_));
    const int tid = tid_, lane = tid & 63, w = __builtin_amdgcn_readfirstlane(tid >> 6), g = lane >> 4, c16 = lane & 15;
    LAS unsigned char* Kt = F.lds + RING_OFF; LAS unsigned char* Vt = F.lds + RING_OFF + 2 * RT_TILE;
    for (int u = F.vcu; u < 256; u += F.G) {
        const int bh = u >> 3, slice = u & 7, b = bh >> 3, h = bh & 7;
        const float lg = ret_log2gamma(h), cdec = exp2f(128.f * lg);
        const size_t tb = (size_t)b * SEQ;
        const int vrow = tid >> 2, vc = tid & 3;
        const bf16* gKp = projb + (tb + (tid >> 4)) * RET_IN + 1024 + h * 128 + (tid & 15) * 8;
        const bf16* gVp = projb + (tb + vrow) * RET_IN + 2048 + h * 256 + slice * 32 + vc * 8;
        const float vscale = exp2f((float)(127 - vrow) * lg);
        v4u rk[4], rv, rk2[4], rv2;
#pragma unroll
        for (int i = 0; i < 4; ++i) rk[i] = *(const v4u*)(gKp + (size_t)(32 * i) * RET_IN);
        rv = *(const v4u*)gVp;
#pragma unroll
        for (int i = 0; i < 4; ++i) rk2[i] = *(const v4u*)(gKp + (size_t)(128 + 32 * i) * RET_IN);
        rv2 = *(const v4u*)(gVp + (size_t)128 * RET_IN);
        f32x4 acc[2]; acc[0] = (f32x4){0.f, 0.f, 0.f, 0.f}; acc[1] = acc[0];
        bf16* stp = ST + ((size_t)bh * 32) * 256 * 128 + (size_t)(slice * 32 + 4 * g) * 128 + 16 * w + c16;
        const int toff = (8 * g + (c16 >> 2)) * RT_STR + (16 * w + 4 * (lane & 3)) * 2;
        const int voff = (8 * g + (c16 >> 2)) * RT_VSTR + (4 * (lane & 3)) * 2;
        for (int n = 0; n < 32; ++n) {
            LAS unsigned char* Kc = Kt + (n & 1) * RT_TILE; LAS unsigned char* Vc = Vt + (n & 1) * RT_VTILE;
#pragma unroll
            for (int i = 0; i < 4; ++i) *(LAS v4u*)(Kc + ((tid >> 4) + 32 * i) * RT_STR + (tid & 15) * 16) = rk[i];
            { v4u o;
#pragma unroll
              for (int j = 0; j < 4; ++j) { const unsigned x = rv[j]; o[j] = cvtpk(__uint_as_float(x << 16) * vscale, __uint_as_float(x & 0xffff0000u) * vscale); }
              *(LAS v4u*)(Vc + vrow * RT_VSTR + vc * 16) = o; }
            LDS_BARRIER();
#pragma unroll
            for (int i = 0; i < 4; ++i) rk[i] = rk2[i];
            rv = rv2;
            if (n + 2 < 32) {
#pragma unroll
                for (int i = 0; i < 4; ++i) rk2[i] = *(const v4u*)(gKp + (size_t)((n + 2) * 128 + 32 * i) * RET_IN);
                rv2 = *(const v4u*)(gVp + (size_t)((n + 2) * 128) * RET_IN);
            }
            { bf16* sp = stp + (size_t)n * 256 * 128;
#pragma unroll
              for (int mt = 0; mt < 2; ++mt)
#pragma unroll
                  for (int r = 0; r < 4; ++r) sp[(16 * mt + r) * 128] = (bf16)(cvtpk(acc[mt][r], 0.f) & 0xffffu); }
            acc[0] = acc[0] * cdec; acc[1] = acc[1] * cdec;
            {   bf16x8 bk[4], av[4][2];
#pragma unroll
                for (int ks = 0; ks < 4; ++ks) { bk[ks] = cat4(lds_tr16(Kc + toff + (32 * ks) * RT_STR), lds_tr16(Kc + toff + (32 * ks + 4) * RT_STR));
#pragma unroll
                    for (int mt = 0; mt < 2; ++mt) av[ks][mt] = cat4(lds_tr16(Vc + voff + (32 * ks) * RT_VSTR + mt * 32), lds_tr16(Vc + voff + (32 * ks + 4) * RT_VSTR + mt * 32)); }
                __builtin_amdgcn_sched_barrier(0);
#pragma unroll
                for (int ks = 0; ks < 4; ++ks)
#pragma unroll
                    for (int mt = 0; mt < 2; ++mt) acc[mt] = mfma16(av[ks][mt], bk[ks], acc[mt]);
            }
        }
        __syncthreads();
    }
}

__device__ __forceinline__ void ret_chunk_phase(Frame& F, const bf16* __restrict__ projb, const bf16* __restrict__ ST, const float* __restrict__ gn_g, const float* __restrict__ gn_b, bf16* __restrict__ mix) {
    int tid_ = threadIdx.x; asm volatile("" : "+v"(tid_));
    const int tid = tid_, lane = tid & 63, w = __builtin_amdgcn_readfirstlane(tid >> 6), g = lane >> 4, c16 = lane & 15;
    LAS unsigned char* Kt = F.lds + RING_OFF; LAS unsigned char* Vt = Kt + RT_TILE; LAS unsigned char* St = Vt + RT_TILE;
    const int srow = tid >> 4, sc = tid & 15;
    for (int u = F.vcu; u < 1024; u += F.G) {
        const int bh = u >> 5, n = u & 31, b = bh >> 3, h = bh & 7;
        const float lg = ret_log2gamma(h);
        const size_t t0 = (size_t)b * SEQ + (size_t)n * 128;
        const bf16* gK = projb + (t0 + srow) * RET_IN + 1024 + h * 128 + sc * 8;
        const bf16* gV = projb + (t0 + srow) * RET_IN + 2048 + h * 256 + sc * 8;
        const bf16* gS = ST + ((size_t)bh * 32 + n) * 256 * 128 + (size_t)srow * 128 + sc * 8;
        v4u rk[4], rv[4], rs[4];
#pragma unroll
        for (int i = 0; i < 4; ++i) { rk[i] = *(const v4u*)(gK + (size_t)(32 * i) * RET_IN); rv[i] = *(const v4u*)(gV + (size_t)(32 * i) * RET_IN); rs[i] = *(const v4u*)(gS + (size_t)(32 * i) * 128); }
        bf16x8 qf[4];
        { const bf16* qp = projb + (t0 + 16 * w + c16) * RET_IN + h * 128 + 8 * g;
#pragma unroll
          for (int ks = 0; ks < 4; ++ks) qf[ks] = *(const bf16x8*)(qp + 32 * ks); }
#pragma unroll
        for (int i = 0; i < 4; ++i) { const int o = (srow + 32 * i) * RT_STR + sc * 16; *(LAS v4u*)(Kt + o) = rk[i]; *(LAS v4u*)(Vt + o) = rv[i]; *(LAS v4u*)(St + o) = rs[i]; }
        __syncthreads();
#pragma unroll
        for (int i = 0; i < 4; ++i) { rv[i] = *(const v4u*)(gV + (size_t)(32 * i) * RET_IN + 128); rs[i] = *(const v4u*)(gS + (size_t)(32 * i) * 128 + 128 * 128); }
        const int irow = 16 * w + c16;
        bf16x8 pf[4];
        {
            const int koff = c16 * RT_STR + 16 * g;
            f32x4 P[8];
#pragma unroll
            for (int mt = 0; mt < 8; ++mt) {
                P[mt] = (f32x4){0.f, 0.f, 0.f, 0.f};
                if (mt <= w) {
                    bf16x8 kf[4];
#pragma unroll
                    for (int ks = 0; ks < 4; ++ks) kf[ks] = *(const LAS bf16x8*)(Kt + koff + mt * 16 * RT_STR + ks * 64);
                    __builtin_amdgcn_sched_barrier(0);
#pragma unroll
                    for (int ks = 0; ks < 4; ++ks) P[mt] = mfma16(kf[ks], qf[ks], P[mt]);
#pragma unroll
                    for (int r = 0; r < 4; ++r) { const int j = 16 * mt + 4 * g + r; P[mt][r] = (j <= irow) ? P[mt][r] * __builtin_amdgcn_exp2f((float)(irow - j) * lg) : 0.f; }
                }
            }
#pragma unroll
            for (int s = 0; s < 4; ++s) pf[s] = pack8(P[2 * s], P[2 * s + 1]);
        }
        const float cdi = __builtin_amdgcn_exp2f((float)(irow + 1) * lg);
        f32x4 acc[2][8];
        const int soff = c16 * RT_STR + 16 * g;
        const int voff = (4 * g + (c16 >> 2)) * RT_STR + 8 * (lane & 3);
#pragma unroll
        for (int hf = 0; hf < 2; ++hf) {
            if (hf == 1) {
                LDS_BARRIER();
#pragma unroll
                for (int i = 0; i < 4; ++i) { const int o = (srow + 32 * i) * RT_STR + sc * 16; *(LAS v4u*)(Vt + o) = rv[i]; *(LAS v4u*)(St + o) = rs[i]; }
                __syncthreads();
            }
#pragma unroll
            for (int mp = 0; mp < 4; ++mp) {
                bf16x8 sf[2][4];
#pragma unroll
                for (int q = 0; q < 2; ++q)
#pragma unroll
                    for (int ks = 0; ks < 4; ++ks) sf[q][ks] = *(const LAS bf16x8*)(St + soff + (2 * mp + q) * 16 * RT_STR + ks * 64);
                __builtin_amdgcn_sched_barrier(0);
#pragma unroll
                for (int q = 0; q < 2; ++q) { f32x4 a = (f32x4){0.f, 0.f, 0.f, 0.f};
#pragma unroll
                    for (int ks = 0; ks < 4; ++ks) a = mfma16(sf[q][ks], qf[ks], a);
                    acc[hf][2 * mp + q] = a * cdi; }
                __builtin_amdgcn_sched_barrier(0);
            }
#pragma unroll
            for (int s = 0; s < 4; ++s) {
                if (2 * s <= w) {
#pragma unroll
                    for (int mp = 0; mp < 2; ++mp) {
                        bf16x8 vf[4];
#pragma unroll
                        for (int q = 0; q < 4; ++q) vf[q] = cat4(lds_tr16(Vt + voff + (32 * s) * RT_STR + (4 * mp + q) * 32), lds_tr16(Vt + voff + (32 * s + 16) * RT_STR + (4 * mp + q) * 32));
                        __builtin_amdgcn_sched_barrier(0);
#pragma unroll
                        for (int q = 0; q < 4; ++q) acc[hf][4 * mp + q] = mfma16(vf[q], pf[s], acc[hf][4 * mp + q]);
                        __builtin_amdgcn_sched_barrier(0);
                    }
                }
            }
        }
        float s1 = 0.f;
#pragma unroll
        for (int hf = 0; hf < 2; ++hf)
#pragma unroll
            for (int mt = 0; mt < 8; ++mt) s1 += (acc[hf][mt][0] + acc[hf][mt][1]) + (acc[hf][mt][2] + acc[hf][mt][3]);
        s1 += __shfl_xor(s1, 16); s1 += __shfl_xor(s1, 32);
        const float mean = s1 * (1.f / 256.f);
        float s2 = 0.f;
#pragma unroll
        for (int hf = 0; hf < 2; ++hf)
#pragma unroll
            for (int mt = 0; mt < 8; ++mt) { const f32x4 d = acc[hf][mt] - mean; s2 += (d[0] * d[0] + d[1] * d[1]) + (d[2] * d[2] + d[3] * d[3]); }
        s2 += __shfl_xor(s2, 16); s2 += __shfl_xor(s2, 32);
        const float rstd = rsqrtf(s2 * (1.f / 256.f) + LN_EPS);
        const size_t trow = t0 + irow;
#pragma unroll
        for (int hf = 0; hf < 2; ++hf)
#pragma unroll
            for (int mt = 0; mt < 8; ++mt) {
                const int c = h * 256 + hf * 128 + 16 * mt + 4 * g;
                typedef unsigned u2_t __attribute__((ext_vector_type(2)));
                const u2_t gw = *(const u2_t*)(projb + trow * RET_IN + 4096 + c);
                const f32x4 gg = *(const f32x4*)(gn_g + c), gb = *(const f32x4*)(gn_b + c);
                const float g0 = __uint_as_float(gw.x << 16), g1 = __uint_as_float(gw.x & 0xffff0000u), g2 = __uint_as_float(gw.y << 16), g3 = __uint_as_float(gw.y & 0xffff0000u);
                const f32x4 o = (acc[hf][mt] - mean) * rstd * gg + gb;
                u2_t ov; ov.x = cvtpk(silu_f(g0) * o[0], silu_f(g1) * o[1]); ov.y = cvtpk(silu_f(g2) * o[2], silu_f(g3) * o[3]);
                *(u2_t*)(mix + trow * RET_MIX + c) = ov;
            }
        __syncthreads();
    }
}
constexpr int GD_STR = 144, GD_TILE = 64 * GD_STR, GD_WAVE_LDS = 3 * GD_TILE + 512;
constexpr int GD_UNIT_ELEMS = 5 * 4096;

__device__ __forceinline__ void gdn_conv64(const bf16* __restrict__ prow, int cb, const float* __restrict__ cw, int nvalid  , float (&out)[64]) {
    float mk[4]; ptrdiff_t ro[4];
#pragma unroll
    for (int k = 0; k < 4; ++k) { const bool ok = (k >= 4 - nvalid); mk[k] = ok ? 1.f : 0.f; ro[k] = ok ? (ptrdiff_t)(k - 3) * HY_LD : 0; }
    v4u xc[4], xn[4];
#pragma unroll
    for (int k = 0; k < 4; ++k) xc[k] = *(const v4u*)(prow + ro[k] + cb);
#pragma unroll
    for (int cc = 0; cc < 8; ++cc) {
        if (cc + 1 < 8) {
#pragma unroll
            for (int k = 0; k < 4; ++k) xn[k] = *(const v4u*)(prow + ro[k] + cb + (cc + 1) * 8);
        }
        asm volatile("" ::: "memory"); __builtin_amdgcn_sched_barrier(0);
        float acc[8];
#pragma unroll
        for (int e = 0; e < 8; ++e) acc[e] = 0.f;
#pragma unroll
        for (int k = 0; k < 4; ++k) {
            const float* wk = cw + k * 1536 + cb + cc * 8;
#pragma unroll
            for (int e2 = 0; e2 < 4; ++e2) { acc[2 * e2] += (wk[2 * e2] * mk[k]) * bflo(xc[k][e2]); acc[2 * e2 + 1] += (wk[2 * e2 + 1] * mk[k]) * bfhi(xc[k][e2]); }
        }
#pragma unroll
        for (int e = 0; e < 8; ++e) out[cc * 8 + e] = silu_f(acc[e]);
#pragma unroll
        for (int k = 0; k < 4; ++k) xc[k] = xn[k];
        asm volatile("" ::: "memory"); __builtin_amdgcn_sched_barrier(0);
    }
}
__device__ __forceinline__ void lds_put_row(LAS unsigned char* rowp, const float (&v)[64], float sc) {
#pragma unroll
    for (int cc = 0; cc < 8; ++cc) { v4u o;
#pragma unroll
        for (int e2 = 0; e2 < 4; ++e2) o[e2] = cvtpk(v[cc * 8 + 2 * e2] * sc, v[cc * 8 + 2 * e2 + 1] * sc);
        *(LAS v4u*)(rowp + cc * 16) = o; }
}
template <int I> __device__ __forceinline__ void fs_row(float (&Tc)[64], const LAS unsigned char* T0, int lane) {
    constexpr int NC = (I + 7) / 8;
    float acc = (I == lane) ? 1.f : 0.f;
    if constexpr (NC > 0) {
        v4u rw[NC];
#pragma unroll
        for (int jc = 0; jc < NC; ++jc) rw[jc] = *(const LAS v4u*)(T0 + I * GD_STR + jc * 16);
#pragma unroll
        for (int jc = 0; jc < NC; ++jc)
#pragma unroll
            for (int e2 = 0; e2 < 4; ++e2) {
                if (jc * 8 + 2 * e2 < I) acc -= bflo(rw[jc][e2]) * Tc[jc * 8 + 2 * e2];
                if (jc * 8 + 2 * e2 + 1 < I) acc -= bfhi(rw[jc][e2]) * Tc[jc * 8 + 2 * e2 + 1];
            }
    }
    Tc[I] = acc;
    __builtin_amdgcn_sched_barrier(0);
}
template <int I0, int I1> struct FsRange {
    static __device__ __forceinline__ void run(float (&Tc)[64], const LAS unsigned char* T0, int lane) {
        if constexpr (I1 - I0 == 1) fs_row<I0>(Tc, T0, lane);
        else { FsRange<I0, (I0 + I1) / 2>::run(Tc, T0, lane); FsRange<(I0 + I1) / 2, I1>::run(Tc, T0, lane); }
    }
};
__device__ __forceinline__ void gdn_prep_unit(const bf16* __restrict__ projb, const float* __restrict__ conv_w, const float* __restrict__ a_log, const float* __restrict__ dt_bias,
                                              bf16* __restrict__ GD, float* __restrict__ GL, int unit, int lane_in, LAS unsigned char* lw) {
    int lane = lane_in; asm volatile("" : "+v"(lane));
    const int bh = unit >> 6, n = unit & 63, b = bh >> 3, h = bh & 7, g = lane >> 4, c16 = lane & 15;
    const size_t t0 = (size_t)b * SEQ + (size_t)n * 64;
    LAS unsigned char* T0 = lw; LAS unsigned char* Kt = lw + GD_TILE; LAS unsigned char* Vt = lw + 2 * GD_TILE;
    LAS float* gbuf = (LAS float*)(lw + 3 * GD_TILE); LAS float* bbuf = gbuf + 64;
    bf16* gd = GD + (size_t)unit * GD_UNIT_ELEMS;
    const bf16* prow = projb + (t0 + lane) * HY_LD + MLA_COLS;
    const int spos = n * 64 + lane; const int nvalid = spos >= 3 ? 4 : spos + 1;
    const float av = bf2f(prow[1536 + h]), bv = bf2f(prow[1544 + h]);
    const float beta = 1.f / (1.f + expf(-bv));
    const float z = av + dt_bias[h];
    const float la = -expf(a_log[h]) * ((z > 20.f) ? z : log1pf(expf(z)));
    float gs = la;
#pragma unroll
    for (int o = 1; o < 64; o <<= 1) { const float t = __shfl_up(gs, o); if (lane >= o) gs += t; }
    const float glast = __shfl(gs, 63);
    const float eg = expf(gs);
    gbuf[lane] = gs; bbuf[lane] = beta;
    if (lane == 0) GL[unit] = expf(glast);
    {
        float r[64];
        gdn_conv64(prow, h * 64, conv_w, nvalid, r);
        float ss = 0.f;
#pragma unroll
        for (int e = 0; e < 64; ++e) ss += r[e] * r[e];
        const float rn = rsqrtf(ss + RMS_EPS) * 0.125f;
        lds_put_row(T0 + lane * GD_STR, r, rn);
        { const float sc = rn * eg; bf16* qg = gd + 3 * 4096 + lane * 64;
#pragma unroll
          for (int cc = 0; cc < 8; ++cc) { v4u o;
#pragma unroll
              for (int e2 = 0; e2 < 4; ++e2) o[e2] = cvtpk(r[cc * 8 + 2 * e2] * sc, r[cc * 8 + 2 * e2 + 1] * sc);
              *(v4u*)(qg + cc * 8) = o; } }
        gdn_conv64(prow, 512 + h * 64, conv_w, nvalid, r);
        ss = 0.f;
#pragma unroll
        for (int e = 0; e < 64; ++e) ss += r[e] * r[e];
        const float rk = rsqrtf(ss + RMS_EPS);
        lds_put_row(Kt + lane * GD_STR, r, rk);
        { const float sc = rk * expf(glast - gs); bf16* kd = gd + 4 * 4096 + lane;
#pragma unroll
          for (int e = 0; e < 64; ++e) kd[e * 64] = (bf16)(cvtpk(r[e] * sc, 0.f) & 0xffffu); }
        gdn_conv64(prow, 1024 + h * 64, conv_w, nvalid, r);
        lds_put_row(Vt + lane * GD_STR, r, 1.f);
    }
    asm volatile("s_waitcnt lgkmcnt(0)" ::: "memory"); __builtin_amdgcn_sched_barrier(0);
    {
        bf16* ai = gd;
#pragma unroll
        for (int m = 0; m < 4; ++m) {
            f32x4 qk[4], kk[4];
#pragma unroll
            for (int nn = 0; nn <= m; ++nn) {
                qk[nn] = (f32x4){0.f, 0.f, 0.f, 0.f}; kk[nn] = qk[nn];
#pragma unroll
                for (int ks = 0; ks < 2; ++ks) {
                    const bf16x8 aq = *(const LAS bf16x8*)(T0 + (16 * m + c16) * GD_STR + (32 * ks + 8 * g) * 2);
                    const bf16x8 ak = *(const LAS bf16x8*)(Kt + (16 * m + c16) * GD_STR + (32 * ks + 8 * g) * 2);
                    const bf16x8 bk = *(const LAS bf16x8*)(Kt + (16 * nn + c16) * GD_STR + (32 * ks + 8 * g) * 2);
                    qk[nn] = mfma16(aq, bk, qk[nn]); kk[nn] = mfma16(ak, bk, kk[nn]);
                }
            }
            asm volatile("s_waitcnt lgkmcnt(0)" ::: "memory"); __builtin_amdgcn_sched_barrier(0);
#pragma unroll
            for (int nn = 0; nn < 4; ++nn) {
                if (nn <= m) {
                    const int j = 16 * nn + c16; const float gj = gbuf[j];
#pragma unroll
                    for (int r = 0; r < 4; ++r) {
                        const int i = 16 * m + 4 * g + r; const float gi = gbuf[i], bi = bbuf[i];
                        const float dec = (i >= j) ? expf(gi - gj) : 0.f;
                        ai[i * 64 + j] = (bf16)(cvtpk(qk[nn][r] * dec, 0.f) & 0xffffu);
                        const float lv = (i > j) ? kk[nn][r] * bi * dec : 0.f;
                        *(LAS bf16*)(T0 + i * GD_STR + j * 2) = (bf16)(cvtpk(lv, 0.f) & 0xffffu);
                    }
                } else {
#pragma unroll
                    for (int r = 0; r < 4; ++r) ai[(16 * m + 4 * g + r) * 64 + 16 * nn + c16] = (bf16)0;
                }
            }
            asm volatile("s_waitcnt lgkmcnt(0)" ::: "memory"); __builtin_amdgcn_sched_barrier(0);
        }
    }
    asm volatile("s_waitcnt lgkmcnt(0)" ::: "memory"); __builtin_amdgcn_sched_barrier(0);
    float Tc[64];
    FsRange<0, 64>::run(Tc, T0, lane);
    asm volatile("s_waitcnt lgkmcnt(0)" ::: "memory"); __builtin_amdgcn_sched_barrier(0);
#pragma unroll
    for (int pass = 0; pass < 2; ++pass) {
        const float sc = pass ? beta * eg : beta;
#pragma unroll
        for (int i = 0; i < 64; ++i) *(LAS bf16*)(T0 + i * GD_STR + lane * 2) = (bf16)(cvtpk(Tc[i] * sc, 0.f) & 0xffffu);
        asm volatile("s_waitcnt lgkmcnt(0)" ::: "memory");
        const LAS unsigned char* Bt = pass ? Kt : Vt;
        bf16* outp = gd + (pass ? 2 : 1) * 4096;
#pragma unroll
        for (int m = 0; m < 4; ++m)
#pragma unroll
            for (int nn = 0; nn < 4; ++nn) {
                f32x4 acc = (f32x4){0.f, 0.f, 0.f, 0.f};
#pragma unroll
                for (int ks = 0; ks < 2; ++ks) {
                    const bf16x8 a = *(const LAS bf16x8*)(T0 + (16 * m + c16) * GD_STR + (32 * ks + 8 * g) * 2);
                    const int ro = (32 * ks + 8 * g + (c16 >> 2)) * GD_STR + (16 * nn + 4 * (lane & 3)) * 2;
                    acc = mfma16(a, cat4(lds_tr16(Bt + ro), lds_tr16(Bt + ro + 4 * GD_STR)), acc);
                }
#pragma unroll
                for (int r = 0; r < 4; ++r) outp[(16 * m + 4 * g + r) * 64 + 16 * nn + c16] = (bf16)(cvtpk(acc[r], 0.f) & 0xffffu);
                __builtin_amdgcn_sched_barrier(0);
            }
        asm volatile("s_waitcnt lgkmcnt(0)" ::: "memory");
    }
}
__device__ __forceinline__ void gdn_prep_phase(Frame& F, const bf16* projb, const float* conv_w, const float* a_log, const float* dt_bias, bf16* GD, float* GL, const Args& args, int cv_lo, int cv_hi) {
    int tid_ = threadIdx.x; asm volatile("" : "+v"(tid_));
    const int tid = tid_, lane = tid & 63, w = __builtin_amdgcn_readfirstlane(tid >> 6);
    if (w < 4) {
        LAS unsigned char* lw = F.lds + RING_OFF + w * GD_WAVE_LDS;
        for (int u = F.vcu * 4 + w; u < 2048; u += F.G * 4) gdn_prep_unit(projb, conv_w, a_log, dt_bias, GD, GL, u, lane, lw);
    } else {
        __builtin_amdgcn_s_setprio(2);
        moe_convert(args, (LAS float*)(F.lds + RING_OFF + 4 * GD_WAVE_LDS + (w - 4) * 8448), lane, cv_lo, cv_hi, F.vcu * 4 + (w - 4), F.G * 4);
        __builtin_amdgcn_s_setprio(0);
    }
    __syncthreads();
}

constexpr int GS_BUF = 5 * GD_TILE, GS_OSTR = 272, GS_OBUF = 64 * GS_OSTR;
__device__ __forceinline__ bf16x8 ld_perm(const LAS unsigned char* p) {
    return cat4(*(const LAS s16x4*)p, *(const LAS s16x4*)(p + 32));
}
__device__ __forceinline__ void gdn_scan_unit(Frame& F, const bf16* __restrict__ GD, const float* __restrict__ GL, const bf16* __restrict__ projb, const float* __restrict__ o_norm, bf16* __restrict__ mix, int bh) {
    int tid_ = threadIdx.x; asm volatile("" : "+v"(tid_));
    const int tid = tid_, lane = tid & 63, w = __builtin_amdgcn_readfirstlane(tid >> 6), g = lane >> 4, c16 = lane & 15;
    LAS unsigned char* Bf = F.lds + RING_OFF; LAS unsigned char* Ob = F.lds + RING_OFF + 2 * GS_BUF;
    const int b = bh >> 3, h = bh & 7;
    const bf16* gsrc = GD + (size_t)bh * 64 * GD_UNIT_ELEMS + (size_t)(tid >> 3) * 64 + (tid & 7) * 8;
    const int ldst = (tid >> 3) * GD_STR + (tid & 7) * 16;
    v4u rg[5];
#pragma unroll
    for (int i = 0; i < 5; ++i) rg[i] = *(const v4u*)(gsrc + i * 4096);
    f32x4 S[4];
#pragma unroll
    for (int m = 0; m < 4; ++m) S[m] = (f32x4){0.f, 0.f, 0.f, 0.f};
    const int aoff = c16 * GD_STR + 8 * g;
    const int row = (tid >> 2) & 63, q4 = tid & 3;
    v4u gpre0, gpre1;
    { const bf16* gp = projb + ((size_t)b * SEQ + row) * HY_LD + MLA_COLS + 1552 + h * 64 + 16 * q4; gpre0 = *(const v4u*)gp; gpre1 = *(const v4u*)(gp + 8); }
    float egl_nx = GL[bh * 64];
    float onr[16];
#pragma unroll
    for (int i = 0; i < 16; ++i) onr[i] = o_norm[16 * q4 + i];
    for (int n = 0; n <= 64; ++n) {
        if (n < 64) {
            LAS unsigned char* Bc = Bf + (n & 1) * GS_BUF;
#pragma unroll
            for (int i = 0; i < 5; ++i) *(LAS v4u*)(Bc + i * GD_TILE + ldst) = rg[i];
        }
        LDS_BARRIER();
        if (n + 1 < 64) {
#pragma unroll
            for (int i = 0; i < 5; ++i) rg[i] = *(const v4u*)(gsrc + (size_t)(n + 1) * GD_UNIT_ELEMS + i * 4096);
        }
        if (w < 4) {
            if (n < 64) {
                const LAS unsigned char* Bc = Bf + (n & 1) * GS_BUF;
                const LAS unsigned char* Ai = Bc; const LAS unsigned char* Ut = Bc + GD_TILE; const LAS unsigned char* Wt = Bc + 2 * GD_TILE;
                const LAS unsigned char* Qg = Bc + 3 * GD_TILE; const LAS unsigned char* Kd = Bc + 4 * GD_TILE;
                const float egl = egl_nx; if (n + 1 < 64) egl_nx = GL[bh * 64 + n + 1];
                bf16x8 sb[2]; sb[0] = pack8(S[0], S[1]); sb[1] = pack8(S[2], S[3]);
                f32x4 vn[4], o[4];
                bf16x8 fw[4][2], fq[4][2]; float uu[4][4];
#pragma unroll
                for (int m = 0; m < 4; ++m)
#pragma unroll
                    for (int s = 0; s < 2; ++s) { fw[m][s] = ld_perm(Wt + aoff + m * 16 * GD_STR + s * 64); fq[m][s] = ld_perm(Qg + aoff + m * 16 * GD_STR + s * 64); }
#pragma unroll
                for (int m = 0; m < 4; ++m)
#pragma unroll
                    for (int r = 0; r < 4; ++r) uu[m][r] = bf2f(*(const LAS bf16*)(Ut + (16 * m + 4 * g + r) * GD_STR + (16 * w + c16) * 2));
                __builtin_amdgcn_sched_barrier(0);
#pragma unroll
                for (int m = 0; m < 4; ++m) {
                    f32x4 a = (f32x4){0.f, 0.f, 0.f, 0.f}; f32x4 oq = a;
#pragma unroll
                    for (int s = 0; s < 2; ++s) { a = mfma16(fw[m][s], sb[s], a); oq = mfma16(fq[m][s], sb[s], oq); }
#pragma unroll
                    for (int r = 0; r < 4; ++r) vn[m][r] = uu[m][r] - a[r];
                    o[m] = oq;
                }
                __builtin_amdgcn_sched_barrier(0);
#pragma unroll
                for (int m = 0; m < 4; ++m)
#pragma unroll
                    for (int s = 0; s < 2; ++s) { fw[m][s] = ld_perm(Ai + aoff + m * 16 * GD_STR + s * 64); fq[m][s] = ld_perm(Kd + aoff + m * 16 * GD_STR + s * 64); }
                bf16x8 vb[2]; vb[0] = pack8(vn[0], vn[1]); vb[1] = pack8(vn[2], vn[3]);
                __builtin_amdgcn_sched_barrier(0);
#pragma unroll
                for (int m = 0; m < 4; ++m) {
                    S[m] = S[m] * egl;
#pragma unroll
                    for (int s = 0; s < 2; ++s) { o[m] = mfma16(fw[m][s], vb[s], o[m]); S[m] = mfma16(fq[m][s], vb[s], S[m]); }
                }
                LAS unsigned char* Oc = Ob + (n & 1) * GS_OBUF;
#pragma unroll
                for (int m = 0; m < 4; ++m)
#pragma unroll
                    for (int r = 0; r < 4; ++r) *(LAS float*)(Oc + (16 * m + 4 * g + r) * GS_OSTR + (16 * w + c16) * 4) = o[m][r];
            }
        } else if (n > 0) {
            const LAS unsigned char* Oc = Ob + ((n - 1) & 1) * GS_OBUF;
            f32x4 v[4]; float ss = 0.f;
#pragma unroll
            for (int i = 0; i < 4; ++i) { v[i] = *(const LAS f32x4*)(Oc + row * GS_OSTR + (16 * q4 + 4 * i) * 4); ss += (v[i][0] * v[i][0] + v[i][1] * v[i][1]) + (v[i][2] * v[i][2] + v[i][3] * v[i][3]); }
            ss += __shfl_xor(ss, 1); ss += __shfl_xor(ss, 2);
            const float rn = rsqrtf(ss * (1.f / 64.f) + RMS_EPS);
            const size_t t = (size_t)b * SEQ + (size_t)(n - 1) * 64 + row;
            const v4u g0 = gpre0, g1 = gpre1;
            if (n < 64) { const bf16* gp = projb + (t + 64) * HY_LD + MLA_COLS + 1552 + h * 64 + 16 * q4; gpre0 = *(const v4u*)gp; gpre1 = *(const v4u*)(gp + 8); }
            v4u o0, o1;
#pragma unroll
            for (int e2 = 0; e2 < 4; ++e2) {
                const int i0 = 2 * e2, i1 = 2 * e2 + 1;
                o0[e2] = cvtpk(v[i0 >> 2][i0 & 3] * rn * onr[i0] * silu_f(bflo(g0[e2])), v[i1 >> 2][i1 & 3] * rn * onr[i1] * silu_f(bfhi(g0[e2])));
                o1[e2] = cvtpk(v[2 + (i0 >> 2)][i0 & 3] * rn * onr[8 + i0] * silu_f(bflo(g1[e2])), v[2 + (i1 >> 2)][i1 & 3] * rn * onr[8 + i1] * silu_f(bfhi(g1[e2])));
            }
            bf16* mp = mix + t * 1024 + 512 + h * 64 + 16 * q4;
            *(v4u*)mp = o0; *(v4u*)(mp + 8) = o1;
        }
    }
    __syncthreads();
}
__device__ __forceinline__ void attn_gdn_phase(Frame& F, const bf16* quk, const bf16* Kr, bf16* mix, const bf16* GD, const float* GL, const bf16* projb, const float* o_norm, gu32* qctr) {
#ifndef REP_SCAN
#define REP_SCAN 1
#endif
    if (F.vcu < 32) for (int rs_ = 0; rs_ < REP_SCAN; ++rs_) gdn_scan_unit(F, GD, GL, projb, o_norm, mix, F.vcu);
    for (;;) {
        if (threadIdx.x == 0) F.MISC[16] = __hip_atomic_fetch_add(qctr, 1u, RLX_AGENT);
        __syncthreads();
        const unsigned k = F.MISC[16];
        __syncthreads();
        if (k >= 512u) break;
        const int qb = 15 - (int)(k >> 5), bh = (int)(k & 31u);
        attn2_unit(F, quk, Kr, mix, bh >> 3, bh & 7, qb);
    }
}
__global__ void __launch_bounds__(NWAVES * 64, 2) mega(Args args) {
    extern __shared__ __attribute__((aligned(16))) unsigned char lds[];
    Frame F;
    F.lds = (LAS unsigned char*)lds; F.MISC = (volatile LAS unsigned*)(F.lds + MISC_OFF);
    F.tid = threadIdx.x; F.lane = F.tid & 63; F.wave = __builtin_amdgcn_readfirstlane(F.tid >> 6);
    F.G = gridDim.x; { const int bx = blockIdx.x; F.vcu = (F.G % 8 == 0) ? (bx % 8) * (F.G / 8) + bx / 8 : bx; }
    F.ctl = (gu32*)(args.ws + WS_CTL);
    for (int u = F.tid; u < (LDS_BYTES - LDSCTL_OFF) / 4; u += NWAVES * 64) ((LAS unsigned*)(F.lds + LDSCTL_OFF))[u] = 0u;
    __syncthreads();
    const int lo = args.ph_lo, hi = args.ph_hi;
#define IN(k) (lo <= (k) && (k) < hi)
    XcdBarrier bar = xcd_barrier_post((unsigned*)(F.ctl + CW_BAR) + args.li * XCD_BAR_WORDS, F.MISC + 8);
#define SEAM2(a, b) do { if (IN(a) && IN(b)) REPEAT(REP_BAR) xcd_barrier(bar); } while (0)
#define SEAM(k) SEAM2(k, (k) + 1)
#define WSP(name) GAS unsigned char* name = (GAS unsigned char*)args.ws; asm volatile("" : "+s"(name))
#define GEMM_PHASE(EPI, SCHED, g, S, E) pg8::gemm_phase<EPI, SCHED, PG8_ALIGN, PG8_SP2>(F.lds + RING_OFF, g, S, E)
#ifndef REP_P0
#define REP_P0 1
#endif
#ifndef REP_INPROJ
#define REP_INPROJ 1
#endif
#ifndef REP_PREP
#define REP_PREP 1
#endif
#ifndef REP_UP
#define REP_UP 1
#endif
#ifndef REP_MIX
#define REP_MIX 1
#endif
#ifndef REP_OUTPROJ
#define REP_OUTPROJ 1
#endif
#ifndef REP_GATHER
#define REP_GATHER 1
#endif
#ifndef REP_MOE
#define REP_MOE 1
#endif
#ifndef REP_PREPO
#define REP_PREPO REP_PREP
#endif
#ifndef REP_MIXO
#define REP_MIXO REP_MIX
#endif
#ifndef REP_BAR
#define REP_BAR 1
#endif
#define REPEAT(n) for (int rep_ = 0; rep_ < (n); ++rep_)
#define MODL(ws, l) ((const float*)(ws + WS_MOD) + (size_t)(l) * NB * 6 * D)
    if (IN(0)) REPEAT(REP_P0) { p0_extras(F, args); p0_weights(F, args);
        { int t_ = threadIdx.x; asm volatile("" : "+v"(t_)); moe_convert(args, (LAS float*)(F.lds + RING_OFF + (t_ >> 6) * 16384), t_ & 63, 0, MOE_ITEMS_PER_LAYER, F.vcu * NWAVES + (t_ >> 6), F.G * NWAVES); } }
    SEAM(0);
    if (IN(1)) { WSP(ws); init_mod_phase(F, args.in[0], args.out, MODL(ws, 0), (bf16*)(ws + WS_HB)); }
    SEAM(1);
    for (int l = 0; l < DEPTH; ++l) {
        const int pb = 2 + l * 16;
        if ((l & 1) == 0) {
            if (IN(pb + 0)) REPEAT(REP_INPROJ) { WSP(ws); const int i = l >> 1; pg8::Gemm g{(const bf16*)(ws + WS_HB), (const bf16*)(ws + WS_WIN) + (size_t)i * HY_LD * D, T, HY_LD, D}; pg8::StaticOrder S; S.init(T, HY_LD, F.G, (int)blockIdx.x);
                pg8::EpiB16 E{(bf16*)(ws + WS_R1), HY_LD, -1}; GEMM_PHASE(pg8::EpiB16, pg8::StaticOrder, g, S, E); }
            SEAM(pb + 0);
            if (IN(pb + 1)) REPEAT(REP_PREP) { WSP(ws); const int i = l >> 1; mla_prep_phase(F, (const bf16*)(ws + WS_R1), (const float*)(ws + WS_CSM), (bf16*)(ws + WS_UPA), (bf16*)(ws + WS_KR));
                gdn_prep_phase(F, (const bf16*)(ws + WS_R1), args.in[14] + (size_t)i * 4 * 1536, args.in[15] + i * 8, args.in[16] + i * 8, (bf16*)(ws + WS_GD), (float*)(ws + WS_GL), args,
                               l == 0 ? MOE_ITEMS_PER_LAYER : MOE_ITEMS_PER_LAYER * 5 / 2, l == 0 ? MOE_ITEMS_PER_LAYER * 5 / 2 : MOE_ITEMS_PER_LAYER * 4); }
            SEAM(pb + 1);
            if (IN(pb + 2)) REPEAT(REP_UP) { WSP(ws); const int i = l >> 1; pg8::Gemm g{(const bf16*)(ws + WS_UPA), (const bf16*)(ws + WS_WUP) + (size_t)i * UP_N * UP_K, T, UP_N, UP_K}; pg8::StaticOrder S; S.init(T, UP_N, F.G, (int)blockIdx.x);
                pg8::EpiQuk E{(bf16*)(ws + WS_QUK), UP_N, (const float*)(ws + WS_CSM)}; GEMM_PHASE(pg8::EpiQuk, pg8::StaticOrder, g, S, E); }
            SEAM(pb + 2);
            if (IN(pb + 3)) REPEAT(REP_MIX) { WSP(ws); const int i = l >> 1; attn_gdn_phase(F, (const bf16*)(ws + WS_QUK), (const bf16*)(ws + WS_KR), (bf16*)(ws + WS_R2), (const bf16*)(ws + WS_GD), (const float*)(ws + WS_GL),
                                                                   (const bf16*)(ws + WS_R1), args.in[17] + i * 64, (gu32*)(ws + WS_CTL) + CW_AQ + 64 * l + 1024 * rep_); }
            SEAM(pb + 3);
            if (IN(pb + 4)) REPEAT(REP_OUTPROJ) { WSP(ws); const int i = l >> 1; pg8::Gemm g{(const bf16*)(ws + WS_R2), (const bf16*)(ws + WS_WOUT) + (size_t)i * D * D, T, D, D}; pg8::StaticOrder S; S.init(T, D, F.G, (int)blockIdx.x);
                pg8::EpiF32 E{(float*)(ws + WS_Y), D, -1}; GEMM_PHASE(pg8::EpiF32, pg8::StaticOrder, g, S, E); }
        } else {
            if (IN(pb + 0)) REPEAT(REP_INPROJ) { WSP(ws); const int i = l >> 1; pg8::Gemm g{(const bf16*)(ws + WS_HB), (const bf16*)(ws + WS_RIN) + (size_t)i * RET_IN * D, T, RET_IN, D}; pg8::StaticOrder S; S.init(T, RET_IN, F.G, (int)blockIdx.x);
                pg8::EpiRet E{(bf16*)(ws + WS_R1), RET_IN, (const float*)(ws + WS_CSR)}; GEMM_PHASE(pg8::EpiRet, pg8::StaticOrder, g, S, E); }
            SEAM(pb + 0);
            if (IN(pb + 1)) REPEAT(REP_PREPO) { WSP(ws); ret_state_phase(F, (const bf16*)(ws + WS_R1), (bf16*)(ws + WS_ST)); }
            SEAM2(pb + 1, pb + 3);
            if (IN(pb + 3)) REPEAT(REP_MIXO) { WSP(ws); const int i = l >> 1; ret_chunk_phase(F, (const bf16*)(ws + WS_R1), (const bf16*)(ws + WS_ST), args.in[20] + (size_t)i * RET_MIX, args.in[21] + (size_t)i * RET_MIX, (bf16*)(ws + WS_R2)); }
            SEAM(pb + 3);
            if (IN(pb + 4)) REPEAT(REP_OUTPROJ) { WSP(ws); const int i = l >> 1; pg8::Gemm g{(const bf16*)(ws + WS_R2), (const bf16*)(ws + WS_ROUT) + (size_t)i * D * RET_MIX, T, D, RET_MIX}; pg8::StaticOrder S; S.init(T, D, F.G, (int)blockIdx.x);
                pg8::EpiF32 E{(float*)(ws + WS_Y), D, -1}; GEMM_PHASE(pg8::EpiF32, pg8::StaticOrder, g, S, E); }
        }
        SEAM(pb + 4);
#ifdef PROBE_LN
        if (IN(pb + 5)) { WSP(ws); ln_router_phase(F, args.out, (float*)(ws + WS_R2 + 96 * MiB), (const float*)(ws + WS_Y), MODL(ws, l), args.in[5] + l * D, args.in[6] + l * D,
                                                     args.in[23] + (size_t)l * D * NG, args.in[24] + l * NG, args.in[25] + (size_t)l * D * NE, args.in[26] + l * NE,
                                                     (bf16*)(ws + WS_R1 + 160 * MiB), (int*)(ws + WS_R1 + 152 * MiB), (float*)(ws + WS_R1 + 153 * MiB), (int*)(ws + WS_R1 + 154 * MiB), (int*)(ws + WS_CTL) + CW_CNT + 64 * l + 512, (int*)(ws + WS_R1 + 156 * MiB)); }
#endif
        if (IN(pb + 5)) { WSP(ws); ln_router_phase(F, args.out, args.out, (const float*)(ws + WS_Y), MODL(ws, l), args.in[5] + l * D, args.in[6] + l * D,
                                                     args.in[23] + (size_t)l * D * NG, args.in[24] + l * NG, args.in[25] + (size_t)l * D * NE, args.in[26] + l * NE,
                                                     (bf16*)(ws + WS_HB), (int*)(ws + WS_TAB_SE), (float*)(ws + WS_TAB_SW), (int*)(ws + WS_TAB_SP), (int*)(ws + WS_CTL) + CW_CNT + 64 * l, (int*)(ws + WS_TOK)); }
        SEAM2(pb + 5, pb + 7);
        if (IN(pb + 7)) REPEAT(REP_MOE) { WSP(ws); const int nt = moe_tables(F, (const int*)(ws + WS_CTL) + CW_CNT + 64 * l);
            pg8::Gemm g{(const bf16*)(ws + WS_HB), (const bf16*)(ws + WS_WGU) + (size_t)l * NE * 1024 * D, XP_ROWS, NE * 1024, D};
            pg8::GroupedOrder S{(const LAS int*)(F.lds + MOE_TAB_OFF), (const int*)(ws + WS_TOK), nt * 4, F.G, (int)blockIdx.x};
            pg8::EpiSiluMul E{(bf16*)(ws + WS_HID), FF}; pg8::gemm_phase<pg8::EpiSiluMul, pg8::GroupedOrder, PG8_ALIGN, PG8_SP2, true>(F.lds + RING_OFF, g, S, E); }
        SEAM(pb + 7);
        if (IN(pb + 8)) REPEAT(REP_MOE) { WSP(ws); const int nt = moe_tables(F, (const int*)(ws + WS_CTL) + CW_CNT + 64 * l);
            pg8::Gemm g{(const bf16*)(ws + WS_HID), (const bf16*)(ws + WS_WD) + (size_t)l * NE * D * FF, XP_ROWS, NE * 1024, FF};
            pg8::GroupedOrder S{(const LAS int*)(F.lds + MOE_TAB_OFF), (const int*)nullptr, nt * 4, F.G, (int)blockIdx.x};
            pg8::EpiB16 E{(bf16*)(ws + WS_R2), D, 3}; GEMM_PHASE(pg8::EpiB16, pg8::GroupedOrder, g, S, E); }
        SEAM(pb + 8);
#ifdef PROBE_LN
        if (IN(pb + 9)) { WSP(ws); ln_ffn_phase(F, args.out, (float*)(ws + WS_R1 + 100 * MiB), (const bf16*)(ws + WS_R2), (const int*)(ws + WS_TAB_SE), (const int*)(ws + WS_TAB_SP), (const int*)(ws + WS_CTL) + CW_CNT + 64 * l, (const float*)(ws + WS_TAB_SW), MODL(ws, l), args.in[7] + l * D, args.in[8] + l * D,
                                                  MODL(ws, l), (bf16*)(ws + WS_R1 + 60 * MiB)); }
#endif
        if (IN(pb + 9)) { WSP(ws); ln_ffn_phase(F, args.out, args.out, (const bf16*)(ws + WS_R2), (const int*)(ws + WS_TAB_SE), (const int*)(ws + WS_TAB_SP), (const int*)(ws + WS_CTL) + CW_CNT + 64 * l, (const float*)(ws + WS_TAB_SW), MODL(ws, l), args.in[7] + l * D, args.in[8] + l * D,
                                                  l + 1 < DEPTH ? MODL(ws, l + 1) : (const float*)nullptr, (bf16*)(ws + WS_HB)); }
        SEAM2(pb + 9, pb + 16);
    }
#undef IN
}
}

#ifndef MK_SPLIT
#define MK_SPLIT 0
#endif
extern "C" void kernel_launch(void* const* d_in, const int* in_sizes, int n_in, void* d_out, int out_size, void* d_ws, size_t ws_size, hipStream_t stream) {
    static int grid = 0;
    if (grid == 0) {
        if (ws_size < WS_END2 || n_in != 30) { fprintf(stderr, "kernel_launch: ws %zu < %zu or n_in %d\n", ws_size, (size_t)WS_END2, n_in); grid = -1; return; }
        int dev = 0, cus = 0;
        if (hipGetDevice(&dev) != hipSuccess || hipDeviceGetAttribute(&cus, hipDeviceAttributeMultiprocessorCount, dev) != hipSuccess) { grid = -1; return; }
        if (hipFuncSetAttribute((const void*)mega, hipFuncAttributeMaxDynamicSharedMemorySize, LDS_BYTES) != hipSuccess) { fprintf(stderr, "kernel_launch: hipFuncSetAttribute failed\n"); grid = -1; return; }
        int per_cu = 0;
        if (hipOccupancyMaxActiveBlocksPerMultiprocessor(&per_cu, (const void*)mega, NWAVES * 64, LDS_BYTES) != hipSuccess || per_cu < 1) fprintf(stderr, "kernel_launch: occupancy query reports %d blocks per CU\n", per_cu);
        (void)hipGetLastError();
        grid = cus;
    }
    if (grid < 0) return;
    unsigned char* ws = (unsigned char*)d_ws;
    (void)hipMemsetAsync(ws + WS_CTL, 0, CTL_ZERO_BYTES, stream);
    Args a{};
    for (int i = 0; i < 30; ++i) a.in[i] = (const float*)d_in[i];
    a.out = (float*)d_out; a.ws = ws;
    const int NPH = 2 + 16 * DEPTH;
#if MK_SPLIT
    int li = 0;
    for (int p = 0; p < NPH; ++p) {
        const int r = (p - 2) & 15; if (p >= 2 && (r >= 10 || (r == 2 && (((p - 2) >> 4) & 1)))) continue;
        a.ph_lo = p; a.ph_hi = p + 1; a.li = li++; hipLaunchKernelGGL(mega, dim3(grid), dim3(NWAVES * 64), LDS_BYTES, stream, a);
    }
#else
    a.ph_lo = 0; a.ph_hi = NPH; a.li = 0;
    hipLaunchKernelGGL(mega, dim3(grid), dim3(NWAVES * 64), LDS_BYTES, stream, a);
#endif
}
```
